# Optimizing an MI355X kernel written in HIP

```python
import math, functools
import jax, jax.numpy as jnp
from jax import lax
import numpy as np

D_MODEL = 1024
BATCH = 8
SEQ = 8192
DEPTH = 1
DEC_BATCH = 8
DEC_SEQ = 16
PAST_LEN = 1024

CHUNK = 64
N_HEADS_A = 8
HEAD_DIM_A = 64
V_DIM_A = 2 * HEAD_DIM_A
Q_WIDTH = N_HEADS_A * 2 * HEAD_DIM_A
ATTN_WIDTH = N_HEADS_A * V_DIM_A
GMLP_CHUNK = 128
GMLP_GROUPS = 8
GMLP_WIDTH = 1024
GMLP_GROUP_DIM = GMLP_WIDTH // GMLP_GROUPS
IN_WIDTH = 2 * Q_WIDTH + ATTN_WIDTH + 2 * GMLP_WIDTH
D_FF = 2816
Q_BLOCK = 128
N_MODS = 9
EPS = 1e-6

kernel_name = "streaming_diffattn_gmlp_macaron_adaln"


def lambda_init_of(layer_idx):
    return 0.8 - 0.6 * math.exp(-0.3 * layer_idx)


def rms_norm(x, g):
    xf = x.astype(jnp.float32)
    y = xf * lax.rsqrt(jnp.mean(xf * xf, axis=-1, keepdims=True) + EPS)
    return (y * g.astype(jnp.float32)).astype(x.dtype)


def swiglu(h, w_gu, w_down):
    gu = h @ w_gu
    return (jax.nn.silu(gu[..., :D_FF]) * gu[..., D_FF:]) @ w_down


def alibi_slopes():
    return jnp.asarray(2.0 ** (-8.0 * np.arange(1, N_HEADS_A + 1) / N_HEADS_A), dtype=jnp.float32)


def alibi_chunk_bias(q_pos, k_pos):
    dist = jnp.abs(q_pos[:, None] - k_pos[None, :]).astype(jnp.float32)
    visible = (k_pos[None, :] // CHUNK) <= (q_pos[:, None] // CHUNK)
    bias = -alibi_slopes()[:, None, None] * dist[None]
    return jnp.where(visible[None], bias, -jnp.inf)


def diff_attn_core(q, k, v, q_pos, k_pos, lam):
    s = jnp.einsum('bqhmd,bkhmd->bhmqk', q, k).astype(jnp.float32) * (HEAD_DIM_A ** -0.5)
    s = s + alibi_chunk_bias(q_pos, k_pos)[None, :, None]
    p = jax.nn.softmax(s, axis=-1)
    a = p[:, :, 0] - lam * p[:, :, 1]
    return jnp.einsum('bhqk,bkhe->bqhe', a.astype(v.dtype), v)


def attend_prompt(q, k, v, lam):
    b, t = q.shape[0], q.shape[1]
    nb = t // Q_BLOCK
    qb = jnp.moveaxis(q.reshape(b, nb, Q_BLOCK, N_HEADS_A, 2, HEAD_DIM_A), 1, 0)
    pos = jnp.arange(t, dtype=jnp.int32)
    posb = pos.reshape(nb, Q_BLOCK)

    def one_block(args):
        qi, pi = args
        return diff_attn_core(qi, k, v, pi, pos, lam)

    o = lax.map(one_block, (qb, posb))
    return jnp.moveaxis(o, 0, 1).reshape(b, t, N_HEADS_A, V_DIM_A)


def attend_sample(q, k, v, lam, ck, cv):
    past = ck.shape[1]
    t = q.shape[1]
    k_all = jnp.concatenate([ck.astype(k.dtype), k], axis=1)
    v_all = jnp.concatenate([cv.astype(v.dtype), v], axis=1)
    k_pos = jnp.arange(past + t, dtype=jnp.int32)
    q_pos = past + jnp.arange(t, dtype=jnp.int32)
    return diff_attn_core(q, k_all, v_all, q_pos, k_pos, lam)


def spatial_gate(u, gv, w_s, b_s):
    b, t, _ = u.shape
    rows = min(t, GMLP_CHUNK)
    n = t // rows
    mask = jnp.tril(jnp.ones((rows, rows), dtype=bool))
    ws = jnp.where(mask[None], w_s[:, :rows, :rows], 0.0).astype(gv.dtype)
    gvr = gv.reshape(b, n, rows, GMLP_GROUPS, GMLP_GROUP_DIM)
    mix = jnp.einsum('gts,bnsgc->bntgc', ws, gvr) + b_s[:, :rows].T[None, None, :, :, None]
    return u * mix.reshape(b, t, GMLP_WIDTH)


def layer_apply(x, c, attend, lambda_init, ada_w, ada_b, norm_g, ffn1_wgu, ffn1_wd, w_in,
                q_norm_g, k_norm_g, lambda_qk, attn_subln_g, gmlp_vnorm_g, gmlp_ws, gmlp_bs,
                w_gate, b_gate, w_branch, w_out, ffn2_wgu, ffn2_wd):
    b, t, _ = x.shape
    mods = (jax.nn.silu(c) @ ada_w + ada_b).reshape(b, N_MODS, D_MODEL)[:, :, None, :]
    sh1, sc1, gt1, sh2, sc2, gt2, sh3, sc3, gt3 = [mods[:, i] for i in range(N_MODS)]
    h = rms_norm(x, norm_g[0]) * (1 + sc1) + sh1
    x = x + 0.5 * gt1 * swiglu(h, ffn1_wgu, ffn1_wd)
    h = rms_norm(x, norm_g[1]) * (1 + sc2) + sh2
    z = h @ w_in
    q = rms_norm(z[..., :Q_WIDTH].reshape(b, t, N_HEADS_A, 2, HEAD_DIM_A), q_norm_g)
    k = rms_norm(z[..., Q_WIDTH:2 * Q_WIDTH].reshape(b, t, N_HEADS_A, 2, HEAD_DIM_A), k_norm_g)
    v = z[..., 2 * Q_WIDTH:2 * Q_WIDTH + ATTN_WIDTH].reshape(b, t, N_HEADS_A, V_DIM_A)
    lq = lambda_qk.astype(jnp.float32)
    lam = jnp.exp(jnp.sum(lq[0] * lq[1])) - jnp.exp(jnp.sum(lq[2] * lq[3])) + lambda_init
    o = attend(q, k, v, lam)
    o = (rms_norm(o, attn_subln_g) * (1.0 - lambda_init)).reshape(b, t, ATTN_WIDTH)
    gz = jax.nn.gelu(z[..., 2 * Q_WIDTH + ATTN_WIDTH:])
    u = gz[..., :GMLP_WIDTH]
    gv = rms_norm(gz[..., GMLP_WIDTH:], gmlp_vnorm_g)
    s = spatial_gate(u, gv, gmlp_ws, gmlp_bs)
    gates = jax.nn.sigmoid(h @ w_gate + b_gate)
    mixed = (gates[..., :D_MODEL] * (o @ w_branch[:ATTN_WIDTH])
             + gates[..., D_MODEL:] * (s @ w_branch[ATTN_WIDTH:]))
    x = x + gt2 * (mixed @ w_out)
    h = rms_norm(x, norm_g[2]) * (1 + sc3) + sh3
    x = x + 0.5 * gt3 * swiglu(h, ffn2_wgu, ffn2_wd)
    return rms_norm(x, norm_g[3]), k, v, gv


def setup_inputs(seed: int = 0) -> dict:
    key = jax.random.key(seed)
    ks = jax.random.split(key, 32)
    f32 = jnp.float32
    nrm = lambda k, shape, s: jax.random.normal(k, shape, f32) * s
    L = DEPTH
    return {
        "x_prompt": nrm(ks[0], (BATCH, SEQ, D_MODEL), 1.0),
        "x_sample": nrm(ks[1], (DEC_BATCH, DEC_SEQ, D_MODEL), 1.0),
        "cache_k": nrm(ks[2], (L, DEC_BATCH, PAST_LEN, N_HEADS_A, 2, HEAD_DIM_A), 1.0),
        "cache_v": nrm(ks[3], (L, DEC_BATCH, PAST_LEN, N_HEADS_A, V_DIM_A), 1.0),
        "c_prompt": nrm(ks[4], (BATCH, D_MODEL), 1.0),
        "c_sample": nrm(ks[5], (DEC_BATCH, D_MODEL), 1.0),
        "ada_w": nrm(ks[6], (L, D_MODEL, N_MODS * D_MODEL), 0.5 * D_MODEL ** -0.5),
        "ada_b": nrm(ks[7], (L, N_MODS * D_MODEL), 0.02),
        "norm_g": 1.0 + nrm(ks[8], (L, 4, D_MODEL), 0.02),
        "ffn1_wgu": nrm(ks[9], (L, D_MODEL, 2 * D_FF), D_MODEL ** -0.5),
        "ffn1_wd": nrm(ks[10], (L, D_FF, D_MODEL), D_FF ** -0.5),
        "w_in": nrm(ks[11], (L, D_MODEL, IN_WIDTH), D_MODEL ** -0.5),
        "q_norm_g": 1.0 + nrm(ks[12], (L, HEAD_DIM_A), 0.02),
        "k_norm_g": 1.0 + nrm(ks[13], (L, HEAD_DIM_A), 0.02),
        "lambda_qk": nrm(ks[14], (L, 4, HEAD_DIM_A), 0.1),
        "attn_subln_g": 1.0 + nrm(ks[15], (L, V_DIM_A), 0.02),
        "gmlp_vnorm_g": 1.0 + nrm(ks[16], (L, GMLP_WIDTH), 0.02),
        "gmlp_ws": nrm(ks[17], (L, GMLP_GROUPS, GMLP_CHUNK, GMLP_CHUNK), GMLP_CHUNK ** -0.5),
        "gmlp_bs": 1.0 + nrm(ks[18], (L, GMLP_GROUPS, GMLP_CHUNK), 0.02),
        "w_gate": nrm(ks[19], (L, D_MODEL, 2 * D_MODEL), D_MODEL ** -0.5),
        "b_gate": nrm(ks[20], (L, 2 * D_MODEL), 0.02),
        "w_branch": nrm(ks[21], (L, ATTN_WIDTH + GMLP_WIDTH, D_MODEL), ATTN_WIDTH ** -0.5),
        "w_out": nrm(ks[22], (L, D_MODEL, D_MODEL), D_MODEL ** -0.5),
        "ffn2_wgu": nrm(ks[23], (L, D_MODEL, 2 * D_FF), D_MODEL ** -0.5),
        "ffn2_wd": nrm(ks[24], (L, D_FF, D_MODEL), D_FF ** -0.5),
    }


def reference(x_prompt, x_sample, cache_k, cache_v, c_prompt, c_sample, ada_w, ada_b, norm_g,
              ffn1_wgu, ffn1_wd, w_in, q_norm_g, k_norm_g, lambda_qk, attn_subln_g, gmlp_vnorm_g,
              gmlp_ws, gmlp_bs, w_gate, b_gate, w_branch, w_out, ffn2_wgu, ffn2_wd):
    xp, xs = x_prompt, x_sample
    kp_list, vp_list, ks_list, vs_list, gs_list = [], [], [], [], []
    for l in range(DEPTH):
        w = (ada_w[l], ada_b[l], norm_g[l], ffn1_wgu[l], ffn1_wd[l], w_in[l], q_norm_g[l],
             k_norm_g[l], lambda_qk[l], attn_subln_g[l], gmlp_vnorm_g[l], gmlp_ws[l], gmlp_bs[l],
             w_gate[l], b_gate[l], w_branch[l], w_out[l], ffn2_wgu[l], ffn2_wd[l])
        lam0 = lambda_init_of(l)
        xp, kp, vp, _ = layer_apply(xp, c_prompt, attend_prompt, lam0, *w)
        xs, kn, vn, gvn = layer_apply(
            xs, c_sample, functools.partial(attend_sample, ck=cache_k[l], cv=cache_v[l]), lam0, *w)
        kp_list.append(kp)
        vp_list.append(vp)
        ks_list.append(kn)
        vs_list.append(vn)
        gs_list.append(gvn)
    k_prompt = jnp.stack(kp_list)
    v_prompt = jnp.stack(vp_list)
    k_sample = jnp.stack(ks_list)
    v_sample = jnp.stack(vs_list)
    gmlp_v_sample = jnp.stack(gs_list)
    return (xp, xs, k_prompt, v_prompt, k_sample, v_sample, gmlp_v_sample)
```

```cpp
#include <hip/hip_runtime.h>
#include <hip/hip_cooperative_groups.h>
#include <cstdio>
#include <cstdint>
namespace cg = cooperative_groups;
namespace pg8 {
#define PG8_LAS __attribute__((address_space(3)))
typedef unsigned short bf16_t;
typedef short bf16x8 __attribute__((ext_vector_type(8)));
typedef float f32x4 __attribute__((ext_vector_type(4)));
typedef unsigned u32x4 __attribute__((ext_vector_type(4)));
constexpr int BM = 256, BK = 64, HALF = 128, HTB = HALF * BK * 2  , STAGE_BYTES = 8 * HTB, NXCD = 8, WGM = 8;

__host__ __device__ __forceinline__ int lds_byte(int r, int c) { const int st = (r >> 4) * 2 + (c >> 5), rr = r & 15, cc = c & 31, ob = rr * 64 + cc * 2; return st * 1024 + (ob ^ (((ob >> 9) & 1) << 5)); }
__host__ __device__ __forceinline__ void stage_rc(int b, int& R, int& C) { const int st = b / 1024, sb = b % 1024, swz = sb ^ (((sb >> 9) & 1) << 5); R = (st >> 1) * 16 + swz / 64; C = (st & 1) * 32 + (swz % 64) / 2; }
__host__ __device__ __forceinline__ int perm32(int rho) { const int n = rho >> 4, i = rho & 15; return 8 * (i >> 2) + 4 * n + (i & 3); }

struct Unit { int pm, pn; };
struct Gemm { const bf16_t* A; const bf16_t* Bt; int M, N, K; };

struct StaticOrder {
    int nM, nN, nwg, G, c;
    __host__ __device__ void init(int M, int N, int G_, int c_) { nM = M / BM; nN = N / BM; nwg = nM * nN; G = G_; c = c_; }
    __host__ __device__ bool next(int i, Unit& u) const {
        const long L = (long)i * G + c; if (L >= nwg) return false;
        int wgid = (int)L; { const int q = nwg / NXCD, r = nwg % NXCD, xcd = wgid % NXCD, off = wgid / NXCD; wgid = (xcd < r ? xcd * (q + 1) : r * (q + 1) + (xcd - r) * q) + off; }
        const int nig = WGM * nN, gid = wgid / nig, fm = gid * WGM, gsz = (nM - fm) < WGM ? (nM - fm) : WGM;
        u.pm = fm + ((wgid % nig) % gsz); u.pn = (wgid % nig) / gsz; return true;
    }
    __device__ __forceinline__ void a_ready(const Unit&) const {}
    __device__ __forceinline__ void done(const Unit&) const {}
};
__device__ __forceinline__ unsigned cvt_pk_bf16(float lo, float hi) { unsigned r; asm volatile("v_cvt_pk_bf16_f32 %0, %1, %2" : "=v"(r) : "v"(lo), "v"(hi)); return r; }
template <class Epi, class Sched, bool ALIGN_EPI = false, bool SP2 = false>
__device__ __forceinline__ void gemm_phase(PG8_LAS unsigned char* lds, const Gemm g, const Sched& S, const Epi& E) {
    int tid_ = threadIdx.x; asm volatile("" : "+v"(tid_));
    const int tid = tid_, wid = __builtin_amdgcn_readfirstlane(tid >> 6), lane = tid & 63, wr = wid >> 2, wc = wid & 3, fr = lane & 15, fq = lane >> 4;
    const int K = g.K, nt = K / BK;
    unsigned voffA[2], voffB[2];
#pragma unroll
    for (int i = 0; i < 2; ++i) { int R, C; stage_rc(tid * 16 + i * 8192, R, C); const int Rb = Epi::PERM ? ((R & ~31) + perm32(R & 31)) : R;
        voffA[i] = (unsigned)(R * K + C) * 2u; voffB[i] = (unsigned)(Rb * K + C) * 2u; }
    const size_t kstep = (size_t)(BK * 2);
    const size_t hstep = (size_t)HALF * K * 2;
    const size_t tstep = 2 * hstep;
    const unsigned ldsw = (unsigned)wid * 1024u;
    const int aoff = lds_byte(wr * 64 + fr, fq * 8), boff = lds_byte(wc * 32 + fr, fq * 8);
#define PG8_SA(b, h) (((b) * 2 + (h)) * HTB)
#define PG8_SB(b, h) ((4 + (b) * 2 + (h)) * HTB)
#define PG8_STAGE(bufoff, gbase, voff) do { _Pragma("unroll") for (int _i = 0; _i < 2; ++_i) \
        __builtin_amdgcn_global_load_lds((const unsigned*)((const char*)(gbase) + (voff)[_i]), (PG8_LAS unsigned*)(lds + (bufoff) + ldsw + _i * 8192), 16, 0, 0); } while (0)
#define PG8_LDA(dst, b, h) do { _Pragma("unroll") for (int m = 0; m < 4; ++m) _Pragma("unroll") for (int k = 0; k < 2; ++k) dst[m][k] = *(const PG8_LAS bf16x8*)(lds + PG8_SA(b, h) + aoff + m * 2048 + k * 1024); } while (0)
#define PG8_LDB(dst, b, h) do { _Pragma("unroll") for (int n = 0; n < 2; ++n) _Pragma("unroll") for (int k = 0; k < 2; ++k) dst[n][k] = *(const PG8_LAS bf16x8*)(lds + PG8_SB(b, h) + boff + n * 2048 + k * 1024); } while (0)
#define PG8_MMA(ai, bj, At, Bt) do { __builtin_amdgcn_s_setprio(1); _Pragma("unroll") for (int m = 0; m < 4; ++m) _Pragma("unroll") for (int n = 0; n < 2; ++n) _Pragma("unroll") for (int k = 0; k < 2; ++k) \
        acc[ai][bj][m][n] = __builtin_amdgcn_mfma_f32_16x16x32_bf16(Bt[n][k], At[m][k], acc[ai][bj][m][n], 0, 0, 0); __builtin_amdgcn_s_setprio(0); } while (0)
#define PG8_WAIT_V(n) asm volatile("s_waitcnt vmcnt(" #n ")" ::: "memory")
#define PG8_WAIT_L(n) asm volatile("s_waitcnt lgkmcnt(" #n ")" ::: "memory")
#define PG8_BAR __builtin_amdgcn_s_barrier()
#define PG8_SCHED __builtin_amdgcn_sched_barrier(0)
    Unit cur, nxt; int ui = 0;
    if (!S.next(0, cur)) return;
    f32x4 acc[2][2][4][2];
#pragma unroll
    for (int a = 0; a < 2; ++a)
#pragma unroll
        for (int b = 0; b < 2; ++b)
#pragma unroll
            for (int m = 0; m < 4; ++m)
#pragma unroll
                for (int n = 0; n < 2; ++n) acc[a][b][m][n] = (f32x4){0.f, 0.f, 0.f, 0.f};
    bf16x8 At[4][2], B0[2][2], B1[2][2];
    const char* cA = (const char*)g.A + (size_t)cur.pm * tstep; const char* cB = (const char*)g.Bt + (size_t)cur.pn * tstep;
    S.a_ready(cur);
    if constexpr (SP2) {
        PG8_STAGE(PG8_SB(0, 0), cB, voffB); PG8_STAGE(PG8_SB(0, 1), cB + hstep, voffB); PG8_STAGE(PG8_SA(0, 0), cA, voffA); PG8_STAGE(PG8_SA(0, 1), cA + hstep, voffA);
        if (wr == 1) PG8_BAR;
        PG8_WAIT_V(2); PG8_BAR;
        PG8_STAGE(PG8_SB(1, 0), cB + kstep, voffB); PG8_STAGE(PG8_SA(1, 0), cA + kstep, voffA); PG8_STAGE(PG8_SB(1, 1), cB + hstep + kstep, voffB);
        PG8_WAIT_V(6); PG8_BAR;
    } else {
        PG8_STAGE(PG8_SB(0, 0), cB, voffB); PG8_STAGE(PG8_SA(0, 0), cA, voffA); PG8_STAGE(PG8_SB(0, 1), cB + hstep, voffB); PG8_STAGE(PG8_SA(0, 1), cA + hstep, voffA);
        if (wr == 1) PG8_BAR;
        PG8_WAIT_V(4); PG8_BAR;
        PG8_STAGE(PG8_SB(1, 0), cB + kstep, voffB); PG8_STAGE(PG8_SA(1, 0), cA + kstep, voffA); PG8_STAGE(PG8_SB(1, 1), cB + hstep + kstep, voffB);
        PG8_WAIT_V(6); PG8_BAR;
    }
    for (;;) {
        const bool has_next = S.next(ui + 1, nxt);
        const char* nA = has_next ? (const char*)g.A + (size_t)nxt.pm * tstep : cA; const char* nB = has_next ? (const char*)g.Bt + (size_t)nxt.pn * tstep : cB;
        for (int t = 0; t < nt; t += 2) {
            const bool last = (t == nt - 2);
            const char* a1 = cA + (size_t)(t + 1) * kstep;
            const char* a2 = last ? nA : cA + (size_t)(t + 2) * kstep; const char* b2 = last ? nB : cB + (size_t)(t + 2) * kstep;
            const char* a3 = a2 + kstep; const char* b3 = b2 + kstep;
            if (last && has_next) S.a_ready(nxt);
            if constexpr (SP2) {
            PG8_LDB(B0, 0, 0); PG8_LDB(B1, 0, 1); PG8_SCHED; PG8_LDA(At, 0, 0); PG8_STAGE(PG8_SA(1, 1), a1 + hstep, voffA);
            PG8_WAIT_V(8); PG8_WAIT_L(0); PG8_BAR; PG8_MMA(0, 0, At, B0); PG8_MMA(0, 1, At, B1); PG8_BAR; PG8_SCHED;
            PG8_LDA(At, 0, 1); PG8_STAGE(PG8_SB(0, 0), b2, voffB); PG8_STAGE(PG8_SB(0, 1), b2 + hstep, voffB); PG8_STAGE(PG8_SA(0, 0), a2, voffA);
            PG8_WAIT_V(8); PG8_WAIT_L(0); PG8_BAR; PG8_MMA(1, 0, At, B0); PG8_MMA(1, 1, At, B1); PG8_BAR; PG8_SCHED;
            PG8_LDB(B0, 1, 0); PG8_LDB(B1, 1, 1); PG8_SCHED; PG8_LDA(At, 1, 0); PG8_STAGE(PG8_SA(0, 1), a2 + hstep, voffA);
            PG8_WAIT_V(8); PG8_WAIT_L(0); PG8_BAR; PG8_MMA(0, 0, At, B0); PG8_MMA(0, 1, At, B1); PG8_BAR; PG8_SCHED;
            PG8_LDA(At, 1, 1); PG8_STAGE(PG8_SB(1, 0), b3, voffB); PG8_STAGE(PG8_SB(1, 1), b3 + hstep, voffB); PG8_STAGE(PG8_SA(1, 0), a3, voffA);
            PG8_WAIT_V(8); PG8_WAIT_L(0); PG8_BAR; PG8_MMA(1, 0, At, B0); PG8_MMA(1, 1, At, B1); PG8_BAR; PG8_SCHED;
            } else {
            PG8_LDB(B0, 0, 0); PG8_SCHED; PG8_LDA(At, 0, 0); PG8_STAGE(PG8_SA(1, 1), a1 + hstep, voffA);
            PG8_WAIT_L(8); PG8_BAR; PG8_WAIT_L(0); PG8_MMA(0, 0, At, B0); PG8_BAR; PG8_SCHED;
            PG8_LDB(B1, 0, 1); PG8_STAGE(PG8_SB(0, 0), b2, voffB);
            PG8_BAR; PG8_WAIT_L(0); PG8_MMA(0, 1, At, B1); PG8_BAR;
            PG8_LDA(At, 0, 1); PG8_STAGE(PG8_SA(0, 0), a2, voffA);
            PG8_BAR; PG8_WAIT_L(0); PG8_MMA(1, 0, At, B0); PG8_BAR; PG8_SCHED;
            PG8_STAGE(PG8_SB(0, 1), b2 + hstep, voffB);
            PG8_WAIT_V(6); PG8_BAR; PG8_MMA(1, 1, At, B1); PG8_BAR;
            PG8_LDB(B0, 1, 0); PG8_SCHED; PG8_LDA(At, 1, 0); PG8_STAGE(PG8_SA(0, 1), a2 + hstep, voffA);
            PG8_WAIT_L(8); PG8_BAR; PG8_WAIT_L(0); PG8_MMA(0, 0, At, B0); PG8_BAR; PG8_SCHED;
            PG8_LDB(B1, 1, 1); PG8_STAGE(PG8_SB(1, 0), b3, voffB);
            PG8_BAR; PG8_WAIT_L(0); PG8_MMA(0, 1, At, B1); PG8_BAR;
            PG8_LDA(At, 1, 1); PG8_STAGE(PG8_SA(1, 0), a3, voffA);
            PG8_BAR; PG8_WAIT_L(0); PG8_MMA(1, 0, At, B0); PG8_BAR; PG8_SCHED;
            PG8_STAGE(PG8_SB(1, 1), b3 + hstep, voffB);
            PG8_WAIT_V(6); PG8_BAR; PG8_MMA(1, 1, At, B1); PG8_BAR;
            }
        }
        if constexpr (ALIGN_EPI) { if (wr == 0) PG8_BAR; }
        if constexpr (!Epi::AFTER_DRAIN) { E(acc, cur, wr, wc, fr, fq); S.done(cur); }
        if (!has_next) break;
#pragma unroll
        for (int a = 0; a < 2; ++a)
#pragma unroll
            for (int b = 0; b < 2; ++b)
#pragma unroll
                for (int m = 0; m < 4; ++m)
#pragma unroll
                    for (int n = 0; n < 2; ++n) acc[a][b][m][n] = (f32x4){0.f, 0.f, 0.f, 0.f};
        cur = nxt; cA = nA; cB = nB; ++ui;
        if constexpr (ALIGN_EPI) { if (wr == 1) PG8_BAR; }
    }
    PG8_WAIT_V(0);
    if constexpr (!ALIGN_EPI) { if (wr == 0) PG8_BAR; }
    PG8_BAR;
    if constexpr (Epi::AFTER_DRAIN) { E.fused(acc, cur, wr, wc, fr, fq, lds, wid, lane); S.done(cur); }
#undef PG8_SA
#undef PG8_SB
#undef PG8_STAGE
#undef PG8_LDA
#undef PG8_LDB
#undef PG8_MMA
#undef PG8_WAIT_V
#undef PG8_WAIT_L
#undef PG8_BAR
#undef PG8_SCHED
}
}

using pg8::bf16_t; using pg8::f32x4; using pg8::u32x4; using pg8::bf16x8;
typedef float f32x16 __attribute__((ext_vector_type(16)));
typedef short v4i16_t __attribute__((ext_vector_type(4)));
typedef unsigned u32x2 __attribute__((ext_vector_type(2)));
#define LAS __attribute__((address_space(3)))

constexpr int D = 1024, MP = 65536, MS = 128, MV = MP + MS, MT = 65792, DFF = 2816, TSEQ = 8192, NMOD = 9216;
constexpr float EPS = 1e-6f, LOG2E = 1.4426950408889634f;
constexpr size_t MiB = 1ull << 20;
constexpr size_t WS_WGU1 = 0, WS_WD1 = 11 * MiB, WS_WIN = 17 * MiB, WS_WGT = 27 * MiB, WS_WBA = 31 * MiB, WS_WBB = 33 * MiB,
                 WS_WOUT = 35 * MiB, WS_WGU2 = 37 * MiB, WS_WD2 = 48 * MiB, WS_MODS = 54 * MiB, WS_SSQ = 55 * MiB, WS_HN = 60 * MiB,
                 WS_R = 189 * MiB, WS_Q = WS_R, WS_KB = WS_R + 129 * MiB, WS_VB = WS_R + 258 * MiB, WS_U = WS_R + 387 * MiB,
                 WS_GV = WS_R + 516 * MiB, WS_END = WS_R + 645 * MiB;
constexpr size_t WS_HID = WS_R, WS_GATES = WS_KB, WS_MIXED = WS_GV;
constexpr size_t WS_WF = 59 * MiB + 65536;
static_assert(WS_SSQ + (size_t)16 * MT * 4 <= WS_WF && WS_WF + 8 * 4 * 8 * 64 * 16 <= WS_HN, "Wf slot");
#ifdef SEP_HN2
constexpr size_t WS_HN2 = 840 * MiB;
#else
constexpr size_t WS_HN2 = WS_HN;
#endif
static_assert((size_t)MT * D * 2 <= 129 * MiB && (size_t)MT * DFF * 2 <= 645 * MiB && (size_t)MT * 2048 * 2 <= 258 * MiB, "ws map");
constexpr size_t O_Y = 0, O_KP = (size_t)MV * D, O_VP = O_KP + (size_t)MP * D, O_KS = O_VP + (size_t)MP * D, O_VS = O_KS + (size_t)MS * D,
                 O_GS = O_VS + (size_t)MS * D, O_END = O_GS + (size_t)MS * D;
constexpr int LDS_BYTES = 139264 + 256;

struct Params { const float* in[25]; float* out; unsigned char* ws; };
typedef const __attribute__((address_space(4))) Params* KP;
__device__ __forceinline__ KP kparams() { KP k = (KP)__builtin_amdgcn_kernarg_segment_ptr(); asm volatile("" : "+s"(k)); return k; }
enum { I_XP = 0, I_XS, I_CK, I_CV, I_CP, I_CS, I_ADAW, I_ADAB, I_NORMG, I_WGU1, I_WD1, I_WIN, I_QG, I_KG, I_LQK, I_SUBG, I_VNG, I_GWS, I_GBS,
       I_WGATE, I_BGATE, I_WBR, I_WOUT, I_WGU2, I_WD2 };

typedef float f32x2_t __attribute__((ext_vector_type(2))); typedef __bf16 bf16x2_t __attribute__((ext_vector_type(2)));
__device__ __forceinline__ unsigned cvt_pk(float lo, float hi) { f32x2_t v = {lo, hi}; bf16x2_t b = __builtin_convertvector(v, bf16x2_t); return __builtin_bit_cast(unsigned, b); }
__device__ __forceinline__ u32x4 pack8(f32x4 a, f32x4 b) { u32x4 w; w.x = cvt_pk(a[0], a[1]); w.y = cvt_pk(a[2], a[3]); w.z = cvt_pk(b[0], b[1]); w.w = cvt_pk(b[2], b[3]); return w; }
__device__ __forceinline__ float bf_lo(unsigned w) { return __uint_as_float(w << 16); }
__device__ __forceinline__ float bf_hi(unsigned w) { return __uint_as_float(w & 0xffff0000u); }
__device__ __forceinline__ float bf2f(bf16_t h) { return __uint_as_float((unsigned)h << 16); }
__device__ __forceinline__ bf16_t f2bf(float f) { return (bf16_t)(cvt_pk(f, 0.f) & 0xffffu); }
__device__ __forceinline__ float fast_rcp(float x) { return __builtin_amdgcn_rcpf(x); }
__device__ __forceinline__ float sigmoidf_(float x) { return fast_rcp(1.f + __builtin_amdgcn_exp2f(-x * LOG2E)); }
__device__ __forceinline__ float siluf_(float x) { return x * sigmoidf_(x); }
__device__ __forceinline__ float geluf_(float x) { const float y = 0.7978845608028654f * (x + 0.044715f * x * x * x); return x * sigmoidf_(2.f * y); }
__device__ __forceinline__ f32x4 gelu4(f32x4 v) { return (f32x4){geluf_(v[0]), geluf_(v[1]), geluf_(v[2]), geluf_(v[3])}; }
__device__ __forceinline__ float wave_sum(float v) {
#pragma unroll
    for (int o = 1; o < 64; o <<= 1) v += __shfl_xor(v, o);
    return v;
}
__device__ __forceinline__ float wave_max(float v) {
#pragma unroll
    for (int o = 1; o < 64; o <<= 1) v = fmaxf(v, __shfl_xor(v, o));
    return v;
}
__device__ __forceinline__ int modidx(int row) { return row < MP ? (row >> 13) : (8 + ((row - MP) >> 4)); }
__device__ __forceinline__ int crow(int r, int hi) { return (r & 3) + 8 * (r >> 2) + 4 * hi; }
#define LDS_WAIT() asm volatile("s_waitcnt lgkmcnt(0)" ::: "memory")
__device__ __forceinline__ int tid_opaque() { int t = threadIdx.x; asm volatile("" : "+v"(t)); return t; }


#ifdef WT_STORES
__device__ __forceinline__ void st_wt(u32x4* p, u32x4 v) { asm volatile("global_store_dwordx4 %0, %1, off sc0 sc1" :: "v"(p), "v"(v) : "memory"); }
__device__ __forceinline__ void st_wt(f32x4* p, f32x4 v) { asm volatile("global_store_dwordx4 %0, %1, off sc0 sc1" :: "v"(p), "v"(v) : "memory"); }
__device__ __forceinline__ void st_wt(u32x2* p, u32x2 v) { asm volatile("global_store_dwordx2 %0, %1, off sc0 sc1" :: "v"(p), "v"(v) : "memory"); }
__device__ __forceinline__ void st_wt(float* p, float v) { asm volatile("global_store_dword %0, %1, off sc0 sc1" :: "v"(p), "v"(v) : "memory"); }
__device__ __forceinline__ void st_wt(bf16_t* p, bf16_t v) { const unsigned w = v; asm volatile("global_store_short %0, %1, off sc0 sc1" :: "v"(p), "v"(w) : "memory"); }
#else
template <class T> __device__ __forceinline__ void st_wt(T* p, T v) { *p = v; }
#endif
struct EpiUp {
    static constexpr bool PERM = true, AFTER_DRAIN = false;
    KP kp; int roff;
    __device__ __forceinline__ void operator()(const f32x4 (&acc)[2][2][4][2], const pg8::Unit& u, int wr, int wc, int fr, int fq) const {
        const int col = u.pn * 128 + wc * 32 + fq * 8; bf16_t* HID = (bf16_t*)(kp->ws + WS_HID);
#pragma unroll
        for (int ai = 0; ai < 2; ++ai)
#pragma unroll
            for (int m = 0; m < 4; ++m) {
                const int row = roff + u.pm * 256 + ai * 128 + wr * 64 + m * 16 + fr;
                f32x4 h0, h1;
#pragma unroll
                for (int i = 0; i < 4; ++i) { h0[i] = siluf_(acc[ai][0][m][0][i]) * acc[ai][1][m][0][i]; h1[i] = siluf_(acc[ai][0][m][1][i]) * acc[ai][1][m][1][i]; }
                st_wt((u32x4*)(HID + (size_t)row * DFF + col), pack8(h0, h1));
            }
    }
};
struct EpiRes {
    static constexpr bool PERM = true, AFTER_DRAIN = false;
    KP kp; int gi; float scale; int base_in; int roff;
    __device__ __forceinline__ void operator()(const f32x4 (&acc)[2][2][4][2], const pg8::Unit& u, int wr, int wc, int fr, int fq) const {
        const int c0 = u.pn * 256 + wc * 32 + fq * 8;
        const float* xp = kp->in[I_XP]; const float* xs = kp->in[I_XS]; float* X = kp->out + O_Y; const float* mods = (const float*)(kp->ws + WS_MODS);
#pragma unroll
        for (int ai = 0; ai < 2; ++ai)
#pragma unroll
            for (int m = 0; m < 4; ++m) {
                const int row = roff + u.pm * 256 + ai * 128 + wr * 64 + m * 16 + fr;
                if (row < MV) {
                    const float* base = base_in ? (row < MP ? xp + (size_t)row * D : xs + (size_t)(row - MP) * D) : X + (size_t)row * D;
                    const float* gt = mods + (size_t)modidx(row) * NMOD + gi * D;
                    float* xo = X + (size_t)row * D;
#pragma unroll
                    for (int bj = 0; bj < 2; ++bj)
#pragma unroll
                        for (int n = 0; n < 2; ++n) {
                            const int c = c0 + bj * 128 + n * 4;
                            const f32x4 b4 = *(const f32x4*)(base + c), g4 = *(const f32x4*)(gt + c);
                            st_wt((f32x4*)(xo + c), b4 + (g4 * scale) * acc[ai][bj][m][n]);
                        }
                }
            }
    }
};
struct EpiIn {
    static constexpr bool PERM = true, AFTER_DRAIN = false;
    KP kp; int roff;
    __device__ __forceinline__ void operator()(const f32x4 (&acc)[2][2][4][2], const pg8::Unit& u, int wr, int wc, int fr, int fq) const {
        const int pn = u.pn;
        unsigned char* ws = kp->ws; float* out = kp->out;
        bf16_t* Q = (bf16_t*)(ws + WS_Q); bf16_t* KB = (bf16_t*)(ws + WS_KB); bf16_t* VB = (bf16_t*)(ws + WS_VB); bf16_t* U = (bf16_t*)(ws + WS_U); bf16_t* GV = (bf16_t*)(ws + WS_GV); float* SSQ = (float*)(ws + WS_SSQ);
        if (pn < 8) {
            const float* qg = kp->in[I_QG]; const float* kg = kp->in[I_KG];
            const bool isq = pn < 4;
            const float* gvec = isq ? qg : kg; const float osc = isq ? LOG2E * 0.125f : 1.f;
            f32x4 gg[2][2];
#pragma unroll
            for (int bj = 0; bj < 2; ++bj)
#pragma unroll
                for (int n = 0; n < 2; ++n) gg[bj][n] = *(const f32x4*)(gvec + 32 * bj + 8 * fq + 4 * n) * osc;
            const int cb = (pn & 3) * 256 + 64 * wc + 8 * fq;
#pragma unroll
            for (int ai = 0; ai < 2; ++ai)
#pragma unroll
                for (int m = 0; m < 4; ++m) {
                    const int row = roff + u.pm * 256 + ai * 128 + wr * 64 + m * 16 + fr;
                    float ss = 0.f;
#pragma unroll
                    for (int bj = 0; bj < 2; ++bj)
#pragma unroll
                        for (int n = 0; n < 2; ++n) { const f32x4 x = acc[ai][bj][m][n]; ss += (x[0] * x[0] + x[1] * x[1]) + (x[2] * x[2] + x[3] * x[3]); }
                    ss += __shfl_xor(ss, 16); ss += __shfl_xor(ss, 32);
                    const float rstd = rsqrtf(ss * (1.f / 64.f) + EPS);
#pragma unroll
                    for (int bj = 0; bj < 2; ++bj) {
                        const f32x4 o0 = acc[ai][bj][m][0] * rstd * gg[bj][0], o1 = acc[ai][bj][m][1] * rstd * gg[bj][1];
                        const int c = cb + 32 * bj;
                        if (isq) { st_wt((u32x4*)(Q + (size_t)row * D + c), pack8(o0, o1)); }
                        else {
                            st_wt((u32x4*)(KB + (size_t)row * D + c), pack8(o0, o1));
                            if (row < MV) { float* kd = out + (row < MP ? O_KP + (size_t)row * D : O_KS + (size_t)(row - MP) * D) + c; st_wt((f32x4*)kd, o0); st_wt((f32x4*)(kd + 4), o1); }
                        }
                    }
                }
        } else {
            const int sec = (pn - 8) >> 2;
            const int cb = ((pn - 8) & 3) * 256 + 32 * wc + 8 * fq;
#pragma unroll
            for (int ai = 0; ai < 2; ++ai)
#pragma unroll
                for (int m = 0; m < 4; ++m) {
                    const int row = roff + u.pm * 256 + ai * 128 + wr * 64 + m * 16 + fr;
                    float ss = 0.f;
#pragma unroll
                    for (int bj = 0; bj < 2; ++bj) {
                        f32x4 o0 = acc[ai][bj][m][0], o1 = acc[ai][bj][m][1];
                        const int c = cb + 128 * bj;
                        if (sec == 0) {
                            st_wt((u32x4*)(VB + (size_t)row * D + c), pack8(o0, o1));
                            if (row < MV) { float* vd = out + (row < MP ? O_VP + (size_t)row * D : O_VS + (size_t)(row - MP) * D) + c; st_wt((f32x4*)vd, o0); st_wt((f32x4*)(vd + 4), o1); }
                        } else {
                            o0 = gelu4(o0); o1 = gelu4(o1);
                            if (sec == 1) { st_wt((u32x4*)(U + (size_t)row * D + c), pack8(o0, o1)); }
                            else {
                                st_wt((u32x4*)(GV + (size_t)row * D + c), pack8(o0, o1));
                                ss += (o0[0] * o0[0] + o0[1] * o0[1]) + (o0[2] * o0[2] + o0[3] * o0[3]) + (o1[0] * o1[0] + o1[1] * o1[1]) + (o1[2] * o1[2] + o1[3] * o1[3]);
                            }
                        }
                    }
                    if (sec == 2) { ss += __shfl_xor(ss, 16); ss += __shfl_xor(ss, 32); if (fq == 0) st_wt(SSQ + (size_t)((pn - 16) * 4 + wc) * MT + row, ss);     }
                }
        }
    }
};
struct EpiGates {
    static constexpr bool PERM = true, AFTER_DRAIN = false;
    KP kp; int roff;
    __device__ __forceinline__ void operator()(const f32x4 (&acc)[2][2][4][2], const pg8::Unit& u, int wr, int wc, int fr, int fq) const {
        const int c0 = u.pn * 256 + wc * 32 + fq * 8;
        bf16_t* G = (bf16_t*)(kp->ws + WS_GATES); const float* bias = kp->in[I_BGATE];
        f32x4 bv[2][2];
#pragma unroll
        for (int bj = 0; bj < 2; ++bj)
#pragma unroll
            for (int n = 0; n < 2; ++n) bv[bj][n] = *(const f32x4*)(bias + c0 + bj * 128 + n * 4);
#pragma unroll
        for (int ai = 0; ai < 2; ++ai)
#pragma unroll
            for (int m = 0; m < 4; ++m) {
                const int row = roff + u.pm * 256 + ai * 128 + wr * 64 + m * 16 + fr;
#pragma unroll
                for (int bj = 0; bj < 2; ++bj) {
                    f32x4 o0 = acc[ai][bj][m][0] + bv[bj][0], o1 = acc[ai][bj][m][1] + bv[bj][1];
#pragma unroll
                    for (int i = 0; i < 4; ++i) { o0[i] = sigmoidf_(o0[i]); o1[i] = sigmoidf_(o1[i]); }
                    st_wt((u32x4*)(G + (size_t)row * 2048 + c0 + bj * 128), pack8(o0, o1));
                }
            }
    }
};
struct EpiBr {
    static constexpr bool PERM = true, AFTER_DRAIN = false;
    KP kp; int goff; int accum; int roff;
    __device__ __forceinline__ void operator()(const f32x4 (&acc)[2][2][4][2], const pg8::Unit& u, int wr, int wc, int fr, int fq) const {
        const int c0 = u.pn * 256 + wc * 32 + fq * 8;
        const bf16_t* G = (const bf16_t*)(kp->ws + WS_GATES); bf16_t* MX = (bf16_t*)(kp->ws + WS_MIXED);
#pragma unroll
        for (int ai = 0; ai < 2; ++ai)
#pragma unroll
            for (int m = 0; m < 4; ++m) {
                const int row = roff + u.pm * 256 + ai * 128 + wr * 64 + m * 16 + fr;
#pragma unroll
                for (int bj = 0; bj < 2; ++bj) {
                    const int c = c0 + bj * 128;
                    const u32x4 g = *(const u32x4*)(G + (size_t)row * 2048 + goff + c);
                    f32x4 o0 = acc[ai][bj][m][0], o1 = acc[ai][bj][m][1];
                    o0 = o0 * (f32x4){bf_lo(g.x), bf_hi(g.x), bf_lo(g.y), bf_hi(g.y)};
                    o1 = o1 * (f32x4){bf_lo(g.z), bf_hi(g.z), bf_lo(g.w), bf_hi(g.w)};
                    bf16_t* mp = MX + (size_t)row * D + c;
                    if (accum) {
                        const u32x4 pv = *(const u32x4*)mp;
                        o0 = o0 + (f32x4){bf_lo(pv.x), bf_hi(pv.x), bf_lo(pv.y), bf_hi(pv.y)};
                        o1 = o1 + (f32x4){bf_lo(pv.z), bf_hi(pv.z), bf_lo(pv.w), bf_hi(pv.w)};
                    }
                    st_wt((u32x4*)mp, pack8(o0, o1));
                }
            }
    }
};

__device__ __forceinline__ void transpose_item(const float* W, int N, int K, int col0, bf16_t* WT, int prow0, int k0, LAS float* scr, int lane) {
#pragma unroll 8
    for (int i = 0; i < 32; ++i) { const int kk = 2 * i + (lane >> 5); scr[kk * 33 + (lane & 31)] = W[(size_t)(k0 + kk) * N + col0 + (lane & 31)]; }
    LDS_WAIT();
    const int c = lane & 7;
#pragma unroll
    for (int j = 0; j < 4; ++j) {
        const int n = (lane >> 3) + 8 * j; const LAS float* s = scr + (8 * c) * 33 + n;
        u32x4 o; o.x = cvt_pk(s[0 * 33], s[1 * 33]); o.y = cvt_pk(s[2 * 33], s[3 * 33]); o.z = cvt_pk(s[4 * 33], s[5 * 33]); o.w = cvt_pk(s[6 * 33], s[7 * 33]);
        st_wt((u32x4*)(WT + (size_t)(prow0 + n) * K + k0 + 8 * c), o);
    }
    LDS_WAIT();
}
__device__ __forceinline__ void transpose_mat(const float* W, int N, int K, int npos, int kind, bf16_t* WT, int item, LAS float* scr, int lane) {
    const int nblk = npos / 32, kb = item / nblk, pb = item % nblk, p0 = pb * 32;
    int col0 = p0;
    if (kind == 1) { const int pn = p0 >> 8, r = p0 & 255; col0 = (r >> 7) * DFF + 128 * pn + (r & 127); }
    else if (kind == 2 && p0 < 2048) { const int pn = p0 >> 8, r = p0 & 255, bj = r >> 7, wc = (r & 127) >> 5; col0 = 256 * pn + 64 * wc + 32 * bj; }
    transpose_item(W, N, K, col0, WT, p0, kb * 64, scr, lane);
}

__device__ __forceinline__ void prologue(KP p, LAS unsigned char* lds, int vcu, int G) {
    const int tid = tid_opaque(), lane = tid & 63, wid = __builtin_amdgcn_readfirstlane(tid >> 6);
    unsigned char* ws = p->ws;
    float* mods = (float*)(ws + WS_MODS);
    if (vcu < NMOD / 64) {
        LAS float* sc = (LAS float*)lds;
        LAS float* red = (LAS float*)(lds + 65536);
        for (int i = tid; i < 16 * D; i += 512) { const int r = i >> 10, k = i & 1023; const float c = r < 8 ? p->in[I_CP][r * D + k] : p->in[I_CS][(r - 8) * D + k]; sc[i] = siluf_(c); }
        __syncthreads();
        const int n0 = vcu * 64;
        float acc[16];
#pragma unroll
        for (int r = 0; r < 16; ++r) acc[r] = 0.f;
        const float* w = p->in[I_ADAW] + (size_t)(128 * wid) * NMOD + n0 + lane;
        for (int k4 = 0; k4 < 32; ++k4) {
            float wv[4];
#pragma unroll
            for (int i = 0; i < 4; ++i) wv[i] = w[(size_t)(k4 * 4 + i) * NMOD];
#pragma unroll
            for (int r = 0; r < 16; ++r) { const f32x4 s4 = *(const LAS f32x4*)(sc + r * D + 128 * wid + 4 * k4); acc[r] += (s4[0] * wv[0] + s4[1] * wv[1]) + (s4[2] * wv[2] + s4[3] * wv[3]); }
        }
#pragma unroll
        for (int r = 0; r < 16; ++r) red[(wid * 16 + r) * 64 + lane] = acc[r];
        __syncthreads();
        for (int o = tid; o < 1024; o += 512) {
            const int r = o >> 6, c = o & 63; float s = 0.f;
#pragma unroll
            for (int w8 = 0; w8 < 8; ++w8) s += red[(w8 * 16 + r) * 64 + c];
            st_wt(mods + (size_t)r * NMOD + n0 + c, s + p->in[I_ADAB][n0 + c]);
        }
        __syncthreads();
    }
    {
        const int e = vcu * 512 + tid;
        if (e < 8 * 4 * 8 * 64) {
            const int ln = e & 63, ks = (e >> 6) & 7, mt = (e >> 9) & 3, gg = e >> 11, r32_ = ln & 31, hi_ = ln >> 5;
            const int t = 32 * mt + r32_, s0 = 16 * ks + 4 * hi_;
            const float* wp = p->in[I_GWS] + (size_t)gg * 16384 + t * 128 + s0;
            f32x4 a0 = *(const f32x4*)wp, a1 = *(const f32x4*)(wp + 8);
#pragma unroll
            for (int i = 0; i < 4; ++i) { if (s0 + i > t) a0[i] = 0.f; if (s0 + 8 + i > t) a1[i] = 0.f; }
            st_wt((u32x4*)(ws + WS_WF) + e, pack8(a0, a1));
        }
    }
    LAS float* scr = (LAS float*)(lds + wid * 16384);
    const int gw = vcu * 8 + wid, NGW = G * 8;
    constexpr int I_UP = 16 * 176, I_DN = 44 * 32, I_IN = 16 * 160, I_GT = 16 * 64, I_SQ = 16 * 32;
    constexpr int NITEMS = 2 * I_UP + 2 * I_DN + I_IN + I_GT + 3 * I_SQ;
    for (int it = gw; it < NITEMS; it += NGW) {
        int r = it;
        if (r < I_UP) { transpose_mat(p->in[I_WGU1], 2 * DFF, D, 2 * DFF, 1, (bf16_t*)(ws + WS_WGU1), r, scr, lane); continue; } r -= I_UP;
        if (r < I_UP) { transpose_mat(p->in[I_WGU2], 2 * DFF, D, 2 * DFF, 1, (bf16_t*)(ws + WS_WGU2), r, scr, lane); continue; } r -= I_UP;
        if (r < I_DN) { transpose_mat(p->in[I_WD1], D, DFF, D, 0, (bf16_t*)(ws + WS_WD1), r, scr, lane); continue; } r -= I_DN;
        if (r < I_DN) { transpose_mat(p->in[I_WD2], D, DFF, D, 0, (bf16_t*)(ws + WS_WD2), r, scr, lane); continue; } r -= I_DN;
        if (r < I_IN) { transpose_mat(p->in[I_WIN], 5120, D, 5120, 2, (bf16_t*)(ws + WS_WIN), r, scr, lane); continue; } r -= I_IN;
        if (r < I_GT) { transpose_mat(p->in[I_WGATE], 2048, D, 2048, 0, (bf16_t*)(ws + WS_WGT), r, scr, lane); continue; } r -= I_GT;
        if (r < I_SQ) { transpose_mat(p->in[I_WBR], D, D, D, 0, (bf16_t*)(ws + WS_WBA), r, scr, lane); continue; } r -= I_SQ;
        if (r < I_SQ) { transpose_mat(p->in[I_WBR] + (size_t)D * D, D, D, D, 0, (bf16_t*)(ws + WS_WBB), r, scr, lane); continue; } r -= I_SQ;
        transpose_mat(p->in[I_WOUT], D, D, D, 0, (bf16_t*)(ws + WS_WOUT), r, scr, lane);
    }
}

__device__ __forceinline__ void norm_rows(KP p, int mode, int vcu, int G) {
    const int tid = tid_opaque(), lane = tid & 63, wid = tid >> 6;
    const int gw = vcu * 8 + wid, NGW = G * 8;
    float* X = p->out + O_Y; bf16_t* HN = (bf16_t*)(p->ws + (mode == 1 ? WS_HN2 : WS_HN)); const float* mods = (const float*)(p->ws + WS_MODS);
    const float* g = p->in[I_NORMG] + mode * D;
    f32x4 g4[4];
#pragma unroll
    for (int j = 0; j < 4; ++j) g4[j] = ((const f32x4*)g)[64 * j + lane];
    for (int row = gw; row < MV; row += NGW) {
        const float* src = mode == 0 ? (row < MP ? p->in[I_XP] + (size_t)row * D : p->in[I_XS] + (size_t)(row - MP) * D) : X + (size_t)row * D;
        f32x4 v[4]; float s = 0.f;
#pragma unroll
        for (int j = 0; j < 4; ++j) { v[j] = ((const f32x4*)src)[64 * j + lane]; s += (v[j][0] * v[j][0] + v[j][1] * v[j][1]) + (v[j][2] * v[j][2] + v[j][3] * v[j][3]); }
        const float rstd = rsqrtf(wave_sum(s) * (1.f / D) + EPS);
        if (mode < 3) {
            const float* sh = mods + (size_t)modidx(row) * NMOD + (3 * mode) * D; const float* sc = sh + D;
            u32x2* o8 = (u32x2*)(HN + (size_t)row * D);
#pragma unroll
            for (int j = 0; j < 4; ++j) {
                const f32x4 s4 = ((const f32x4*)sc)[64 * j + lane], h4 = ((const f32x4*)sh)[64 * j + lane];
                const f32x4 o = (v[j] * rstd) * g4[j] * (s4 + 1.f) + h4;
                u32x2 w; w.x = cvt_pk(o[0], o[1]); w.y = cvt_pk(o[2], o[3]); st_wt(o8 + 64 * j + lane, w);
            }
        } else {
#ifdef PROBE_YS
            const float pfac = row < MP ? PROBE_YS : 1.f;
#else
            const float pfac = 1.f;
#endif
#pragma unroll
            for (int j = 0; j < 4; ++j) ((f32x4*)(X + (size_t)row * D))[64 * j + lane] = (v[j] * (rstd * pfac)) * g4[j];
        }
    }
}

#ifndef PROBE_EXPLICIT_BIAS
#define PROBE_EXPLICIT_BIAS 0
#endif
__device__ __forceinline__ void glds16(const void* gsrc, unsigned lds_dst) {
    unsigned keep; const unsigned dst = (unsigned)__builtin_amdgcn_readfirstlane((int)lds_dst);
    asm volatile("s_mov_b32 %0, m0\n\ts_mov_b32 m0, %2\n\ts_nop 0\n\tglobal_load_lds_dwordx4 %1, off\n\ts_mov_b32 m0, %0" : "=&s"(keep) : "v"(gsrc), "s"(dst) : "memory");
}
__device__ __forceinline__ v4i16_t vtr(const LAS unsigned char* p) { return __builtin_amdgcn_ds_read_tr16_b64_v4i16((LAS v4i16_t*)p); }
__device__ __forceinline__ void attn_unit(const bf16_t* Q, const bf16_t* Kb, const bf16_t* Vb, bf16_t* O, const float* subg,
                                          int b, int h, int j, LAS unsigned char* lds, float lam, float M2, float win) {
    const int tid = tid_opaque(), lane = tid & 63, r32 = lane & 31, hi = lane >> 5;
    const int wid = __builtin_amdgcn_readfirstlane(tid >> 6);
    const int m = wid & 1, rg = wid >> 1;
    const int q0 = 128 * j + 32 * rg, myc = 2 * j + (rg >> 1), ntiles = 2 * j + 2;
    int kt0 = (int)floorf((128.f * (float)j - 63.f - win) * (1.f / 64.f)) + 1; kt0 = kt0 < 0 ? 0 : kt0;
    const size_t rowbase = (size_t)b * TSEQ;
    const float slope2 = ldexpf(LOG2E, -(h + 1));
    const bf16_t* ksrc = Kb + (rowbase + (tid & 63)) * D + h * 128 + (tid >> 6) * 8;
    const bf16_t* vsrc = Vb + (rowbase + 16 * (wid & 3) + (lane >> 2)) * D + h * 128 + 32 * (wid >> 2) + 8 * (lane & 3);
    bf16x8 qr[4];
    { const bf16_t* qw = Q + (rowbase + q0 + r32) * D + h * 128 + m * 64 + 8 * hi;
#pragma unroll
      for (int d0 = 0; d0 < 4; ++d0) qr[d0] = *(const bf16x8*)(qw + 16 * d0); }
    asm volatile("" : "+v"(qr[0]), "+v"(qr[1]), "+v"(qr[2]), "+v"(qr[3]));
    const float pa = -slope2 * (float)(r32 - 4 * hi);
    f32x16 o[4];
#pragma unroll
    for (int d0 = 0; d0 < 4; ++d0)
#pragma unroll
        for (int r = 0; r < 16; ++r) o[d0][r] = 0.f;
    float lsum = 0.f;
    const int koff = (m * 8 + hi) * 1024 + r32 * 16;
    const int voff = 16384 + ((lane >> 4) & 1) * 32 + (lane & 3) * 8 + (4 * hi + ((lane & 15) >> 2)) * 64;
    const unsigned lbase = (unsigned)(uintptr_t)lds + (unsigned)wid * 1024u;
#define ATT_STAGE(kt_, s_) do { const size_t go_ = (size_t)(kt_) * 64 * D; const unsigned lb_ = lbase + (unsigned)(s_) * 32768u; \
        glds16(ksrc + go_, lb_); glds16(ksrc + go_ + 64, lb_ + 8192u); glds16(vsrc + go_, lb_ + 16384u); glds16(vsrc + go_ + 64, lb_ + 24576u); } while (0)
    ATT_STAGE(kt0, kt0 & 3); ATT_STAGE(kt0 + 1, (kt0 + 1) & 3);
    if (kt0 + 2 < ntiles) { ATT_STAGE(kt0 + 2, (kt0 + 2) & 3); asm volatile("s_waitcnt vmcnt(8)" ::: "memory"); }
    else asm volatile("s_waitcnt vmcnt(4)" ::: "memory");
    __syncthreads();
    for (int kt = kt0; kt < ntiles; ++kt) {
        const LAS unsigned char* buf = lds + (kt & 3) * 32768;
        const bool more = kt + 3 < ntiles;
        if (more) ATT_STAGE(kt + 3, (kt + 3) & 3);
        if (kt <= myc) {
            f32x16 p0, p1;
            if (kt < myc && !PROBE_EXPLICIT_BIAS) {
                const float c0 = pa - slope2 * (float)(q0 - 64 * kt) - M2, c1 = c0 + 32.f * slope2;
#pragma unroll
                for (int r = 0; r < 16; ++r) { const float kr = (float)((r & 3) + 8 * (r >> 2)); p0[r] = fmaf(slope2, kr, c0); p1[r] = fmaf(slope2, kr, c1); }
            } else {
#pragma unroll
                for (int r = 0; r < 16; ++r) { const float dq = (float)(q0 + r32 - 64 * kt - crow(r, hi)); p0[r] = -slope2 * fabsf(dq) - M2; p1[r] = -slope2 * fabsf(dq - 32.f) - M2; }
            }
            const LAS unsigned char* kb = buf + koff;
            bf16x8 kf[8];
#pragma unroll
            for (int d0 = 0; d0 < 4; ++d0) { kf[2 * d0] = *(const LAS bf16x8*)(kb + d0 * 2048); kf[2 * d0 + 1] = *(const LAS bf16x8*)(kb + d0 * 2048 + 512); }
            __builtin_amdgcn_sched_barrier(0);
#pragma unroll
            for (int d0 = 0; d0 < 4; ++d0) {
                p0 = __builtin_amdgcn_mfma_f32_32x32x16_bf16(kf[2 * d0], qr[d0], p0, 0, 0, 0);
                p1 = __builtin_amdgcn_mfma_f32_32x32x16_bf16(kf[2 * d0 + 1], qr[d0], p1, 0, 0, 0);
            }
            float sa = 0.f, sb = 0.f;
#pragma unroll
            for (int r = 0; r < 16; ++r) { p0[r] = __builtin_amdgcn_exp2f(p0[r]); p1[r] = __builtin_amdgcn_exp2f(p1[r]); sa += p0[r]; sb += p1[r]; }
            lsum += sa + sb;
            u32x4 pw[4];
            pw[0] = (u32x4){cvt_pk(p0[0], p0[1]), cvt_pk(p0[2], p0[3]), cvt_pk(p0[4], p0[5]), cvt_pk(p0[6], p0[7])};
            pw[1] = (u32x4){cvt_pk(p0[8], p0[9]), cvt_pk(p0[10], p0[11]), cvt_pk(p0[12], p0[13]), cvt_pk(p0[14], p0[15])};
            pw[2] = (u32x4){cvt_pk(p1[0], p1[1]), cvt_pk(p1[2], p1[3]), cvt_pk(p1[4], p1[5]), cvt_pk(p1[6], p1[7])};
            pw[3] = (u32x4){cvt_pk(p1[8], p1[9]), cvt_pk(p1[10], p1[11]), cvt_pk(p1[12], p1[13]), cvt_pk(p1[14], p1[15])};
            const LAS unsigned char* vb = buf + voff;
#pragma unroll
            for (int d0 = 0; d0 < 4; ++d0) {
                v4i16_t lo[4], hh[4];
#pragma unroll
                for (int ks = 0; ks < 4; ++ks) { lo[ks] = vtr(vb + d0 * 4096 + ks * 1024); hh[ks] = vtr(vb + d0 * 4096 + ks * 1024 + 512); }
#pragma unroll
                for (int ks = 0; ks < 4; ++ks) {
                    const bf16x8 vf = (bf16x8){lo[ks][0], lo[ks][1], lo[ks][2], lo[ks][3], hh[ks][0], hh[ks][1], hh[ks][2], hh[ks][3]};
                    o[d0] = __builtin_amdgcn_mfma_f32_32x32x16_bf16(__builtin_bit_cast(bf16x8, pw[ks]), vf, o[d0], 0, 0, 0);
                }
            }
        }
        if (more) asm volatile("s_waitcnt vmcnt(8)" ::: "memory");
        else asm volatile("s_waitcnt vmcnt(0)" ::: "memory");
        __syncthreads();
    }
    lsum += __shfl_xor(lsum, 32);
    LAS float* wsf = (LAS float*)(lds + 131072) + wid * 32;
    if (hi == 0) wsf[r32] = lsum;
    LDS_WAIT();
    float f[16];
    const float fs = m == 0 ? 1.f : -lam;
#pragma unroll
    for (int r = 0; r < 16; ++r) f[r] = fs / wsf[crow(r, hi)];
    LAS float* CB = (LAS float*)lds;
    if (m == 1) {
#pragma unroll
        for (int d0 = 0; d0 < 4; ++d0)
#pragma unroll
            for (int r = 0; r < 16; ++r) CB[(32 * rg + crow(r, hi)) * 132 + 32 * d0 + r32] = o[d0][r] * f[r];
    }
    __syncthreads();
    if (m == 0) {
#pragma unroll
        for (int d0 = 0; d0 < 4; ++d0)
#pragma unroll
            for (int r = 0; r < 16; ++r) CB[(32 * rg + crow(r, hi)) * 132 + 32 * d0 + r32] += o[d0][r] * f[r];
    }
    __syncthreads();
    {
        const int row = tid >> 2, part = tid & 3;
        f32x4 v[8]; float ss = 0.f;
#pragma unroll
        for (int i = 0; i < 8; ++i) { v[i] = *(const LAS f32x4*)(CB + row * 132 + 32 * part + 4 * i); ss += (v[i][0] * v[i][0] + v[i][1] * v[i][1]) + (v[i][2] * v[i][2] + v[i][3] * v[i][3]); }
        ss += __shfl_xor(ss, 1); ss += __shfl_xor(ss, 2);
        const float rstd = rsqrtf(ss * (1.f / 128.f) + EPS) * 0.8f;
        bf16_t* op = O + (rowbase + 128 * j + row) * D + h * 128 + 32 * part;
#pragma unroll
        for (int i = 0; i < 4; ++i) {
            const f32x4 ga = *(const f32x4*)(subg + 32 * part + 8 * i), gb = *(const f32x4*)(subg + 32 * part + 8 * i + 4);
            st_wt((u32x4*)(op + 8 * i), pack8(v[2 * i] * rstd * ga, v[2 * i + 1] * rstd * gb));
        }
    }
    __syncthreads();
#undef ATT_STAGE
}

__device__ __forceinline__ void spatial_unit(const bf16_t* GV, bf16_t* US, const float* SSQ, const float* vg, const float* Ws, const float* bs, int ci, LAS unsigned char* lds, const unsigned char* WFp, unsigned char* DBGP = nullptr, bf16_t* USo = nullptr) {
    const int tid = tid_opaque(), lane = tid & 63, r32 = lane & 31, hi = lane >> 5;
    const int g = __builtin_amdgcn_readfirstlane(tid >> 6);
    LAS unsigned char* wbuf = lds + g * 16384;
    LAS float* rst = (LAS float*)(lds + 131072) + g * 128;
    const int R0 = 128 * ci;
#pragma unroll
    for (int i = 0; i < 2; ++i) {
        const int rr = lane + 64 * i; float s = 0.f;
#pragma unroll
        for (int sl = 0; sl < 16; ++sl) s += SSQ[(size_t)sl * MT + R0 + rr];
        rst[rr] = rsqrtf(s * (1.f / 1024.f) + EPS);
    }
    LDS_WAIT();
    const int laneoff = ((lane >> 4) & 1) * 32 + (lane & 3) * 8 + (4 * hi + ((lane & 15) >> 2)) * 64;
    const float* Wg = Ws + (size_t)g * 16384; (void)Wg;
    const u32x4* Wf = (const u32x4*)WFp;
    for (int hh = 0; hh < 2; ++hh) {
#pragma unroll 4
        for (int pc = 0; pc < 16; ++pc) {
            const int d0 = pc >> 3, ks = pc & 7, row = 16 * ks + (lane >> 2), col = g * 128 + 64 * hh + 32 * d0 + 8 * (lane & 3);
            const u32x4 raw = *(const u32x4*)(GV + (size_t)(R0 + row) * D + col);
            const float rs = rst[row];
            const f32x4 ga = *(const f32x4*)(vg + col) * rs, gb = *(const f32x4*)(vg + col + 4) * rs;
            const f32x4 a = (f32x4){bf_lo(raw.x), bf_hi(raw.x), bf_lo(raw.y), bf_hi(raw.y)} * ga, b4 = (f32x4){bf_lo(raw.z), bf_hi(raw.z), bf_lo(raw.w), bf_hi(raw.w)} * gb;
            *(LAS u32x4*)(wbuf + pc * 1024 + lane * 16) = pack8(a, b4);
        }
        LDS_WAIT();
#pragma unroll 1
        for (int mt = 0; mt < 4; ++mt) {
            f32x16 o[2];
#pragma unroll
            for (int nt = 0; nt < 2; ++nt)
#pragma unroll
                for (int r = 0; r < 16; ++r) o[nt][r] = 0.f;
#pragma unroll 2
            for (int ks = 0; ks < 2 * mt + 2; ++ks) {
                bf16x8 vf[2];
#pragma unroll
                for (int nt = 0; nt < 2; ++nt) {
                    const v4i16_t lo = vtr(wbuf + nt * 8192 + ks * 1024 + laneoff), hh2 = vtr(wbuf + nt * 8192 + ks * 1024 + 512 + laneoff);
                    vf[nt] = (bf16x8){lo[0], lo[1], lo[2], lo[3], hh2[0], hh2[1], hh2[2], hh2[3]};
                }
                const bf16x8 af = __builtin_bit_cast(bf16x8, Wf[((g * 4 + mt) * 8 + ks) * 64 + lane]);
#pragma unroll
                for (int nt = 0; nt < 2; ++nt) o[nt] = __builtin_amdgcn_mfma_f32_32x32x16_bf16(af, vf[nt], o[nt], 0, 0, 0);
            }
#ifdef SELFCHK2
            {
                const int tt = 32 * mt + crow(5, hi), col = g * 128 + 64 * hh + 32 + r32;
                float mixn = bs[g * 128 + tt];
                for (int s = 0; s <= tt; ++s) mixn += Wg[tt * 128 + s] * (bf2f(GV[(size_t)(R0 + s) * D + col]) * rst[s] * vg[col]);
                const float mf = o[1][5] + bs[g * 128 + tt];
                const float rel = fabsf(mf - mixn) / (fabsf(mixn) + 0.1f);
                if (rel > 0.05f) atomicAdd((unsigned*)DBGP + 1, 1u);
                atomicAdd((unsigned*)DBGP + 2, 1u);
            }
#endif
#pragma unroll
            for (int r = 0; r < 16; ++r) {
                const int tt = 32 * mt + crow(r, hi); const float bb = bs[g * 128 + tt];
#pragma unroll
                for (int nt = 0; nt < 2; ++nt) {
                    bf16_t* up = US + (size_t)(R0 + tt) * D + g * 128 + 64 * hh + 32 * nt + r32;
                    bf16_t* uo = (USo ? USo : US) + (size_t)(R0 + tt) * D + g * 128 + 64 * hh + 32 * nt + r32;
#ifdef PROBE_NOWV
                    st_wt(uo, f2bf(bf2f(*up) * (0.f * o[nt][r] + bb)));
#else
                    st_wt(uo, f2bf(bf2f(*up) * (o[nt][r] + bb)));
#endif
                }
            }
        }
        LDS_WAIT();
    }
}

__device__ __forceinline__ void sample_spatial_unit(const bf16_t* GV, bf16_t* US, const float* SSQ, const float* vg, const float* Ws, const float* bs, float* gs_out, int b, LAS unsigned char* lds) {
    const int tid = tid_opaque();
    LAS float* rst = (LAS float*)lds;
    if (tid < 16) { float s = 0.f; for (int i = 0; i < 16; ++i) s += SSQ[(size_t)i * MT + MP + 16 * b + tid]; rst[tid] = rsqrtf(s * (1.f / 1024.f) + EPS); }
    __syncthreads();
    for (int c = tid; c < D; c += 512) {
        const int g = c >> 7; const float gc = vg[c];
        float gvn[16];
#pragma unroll
        for (int s = 0; s < 16; ++s) { gvn[s] = bf2f(GV[(size_t)(MP + 16 * b + s) * D + c]) * rst[s] * gc; gs_out[(size_t)(16 * b + s) * D + c] = gvn[s]; }
#pragma unroll
        for (int t = 0; t < 16; ++t) {
            float mix = bs[g * 128 + t];
#pragma unroll
            for (int s = 0; s < 16; ++s) if (s <= t) mix += Ws[(size_t)g * 16384 + t * 128 + s] * gvn[s];
            bf16_t* up = US + (size_t)(MP + 16 * b + t) * D + c;
            st_wt(up, f2bf(bf2f(*up) * mix));
        }
    }
    __syncthreads();
}

__device__ __forceinline__ void sample_attn_unit(KP p, const bf16_t* Q, bf16_t* O, int b, int h, int qg4, float lam, LAS unsigned char* lds) {
    const int tid = tid_opaque(), lane = tid & 63, wid = tid >> 6;
    constexpr int NK = 1040;
    LAS float* qs = (LAS float*)lds;
    LAS float* scb = (LAS float*)(lds + 8192);
    LAS float* lrow = (LAS float*)(lds + 8192 + 4 * NK * 4);
    LAS float* red = lrow + 4;
    LAS float* part = (LAS float*)(lds + 32768);
    const float* KS = p->out + O_KS; const float* VS = p->out + O_VS;
    const float slope2 = ldexpf(LOG2E, -(h + 1));
    const int qrow0 = 16 * b + 4 * qg4;
    { const int mm = tid >> 8, q = (tid >> 6) & 3, dd = tid & 63; qs[tid] = bf2f(Q[(size_t)(MP + qrow0 + q) * D + h * 128 + mm * 64 + dd]); }
    __syncthreads();
    const int qi = tid >> 7, d = tid & 127;
    float res = 0.f;
    for (int m = 0; m < 2; ++m) {
        for (int kk = tid; kk < NK; kk += 512) {
            const float* kp = kk < 1024 ? p->in[I_CK] + (((size_t)b * 1024 + kk) * 8 + h) * 128 + m * 64 : KS + (size_t)(16 * b + kk - 1024) * D + h * 128 + m * 64;
            f32x4 kv[16];
#pragma unroll
            for (int i = 0; i < 16; ++i) kv[i] = ((const f32x4*)kp)[i];
#pragma unroll
            for (int q = 0; q < 4; ++q) {
                const LAS f32x4* qp = (const LAS f32x4*)(qs + (m * 4 + q) * 64);
                float dot = 0.f;
#pragma unroll
                for (int i = 0; i < 16; ++i) { const f32x4 q4 = qp[i]; dot += (q4[0] * kv[i][0] + q4[1] * kv[i][1]) + (q4[2] * kv[i][2] + q4[3] * kv[i][3]); }
                scb[q * NK + kk] = dot - slope2 * fabsf((float)(1024 + 4 * qg4 + q - kk));
            }
        }
        __syncthreads();
        if (wid < 4) {
            float mx = -3.0e38f;
            for (int kk = lane; kk < NK; kk += 64) mx = fmaxf(mx, scb[wid * NK + kk]);
            mx = wave_max(mx);
            float sum = 0.f;
            for (int kk = lane; kk < NK; kk += 64) { const float e = __builtin_amdgcn_exp2f(scb[wid * NK + kk] - mx); scb[wid * NK + kk] = e; sum += e; }
            sum = wave_sum(sum);
            if (lane == 0) lrow[wid] = sum;
        }
        __syncthreads();
        {
            const int ksl = tid >> 7, k0 = ksl * 260, k1 = k0 + 260;
            float a4[4] = {0.f, 0.f, 0.f, 0.f};
            const float* cv = p->in[I_CV] + ((size_t)b * 1024 * 8 + h) * 128 + d;
#pragma unroll 8
            for (int kk = k0; kk < k1; ++kk) {
                const float v = kk < 1024 ? cv[(size_t)kk * 1024] : VS[(size_t)(16 * b + kk - 1024) * D + h * 128 + d];
#pragma unroll
                for (int q = 0; q < 4; ++q) a4[q] += scb[q * NK + kk] * v;
            }
#pragma unroll
            for (int q = 0; q < 4; ++q) part[(ksl * 4 + q) * 128 + d] = a4[q];
            __syncthreads();
            const float acc = (part[(0 * 4 + qi) * 128 + d] + part[(1 * 4 + qi) * 128 + d]) + (part[(2 * 4 + qi) * 128 + d] + part[(3 * 4 + qi) * 128 + d]);
            res += (m == 0 ? 1.f : -lam) * acc / lrow[qi];
        }
        __syncthreads();
    }
    { const float s = wave_sum(res * res); if (lane == 0) red[wid] = s; }
    __syncthreads();
    const float tot = red[2 * qi] + red[2 * qi + 1];
    const float rstd = rsqrtf(tot * (1.f / 128.f) + EPS);
    st_wt(O + (size_t)(MP + qrow0 + qi) * D + h * 128 + d, f2bf(res * rstd * p->in[I_SUBG][d] * 0.8f));
    __syncthreads();
}

#if defined(SELFCHK) || defined(O_SEPARATE)
constexpr size_t WS_O2 = 840 * MiB;
#endif
#ifdef SELFCHK
constexpr size_t WS_DBG = WS_END + 32768;
__device__ __forceinline__ void check_attn_rows(KP p, int b, int h, int t0, float lam, LAS unsigned char* lds) {
    const int tid = tid_opaque(), lane = tid & 63, wid = tid >> 6;
    const bf16_t* Q = (const bf16_t*)(p->ws + WS_Q); const bf16_t* KB = (const bf16_t*)(p->ws + WS_KB); const bf16_t* VB = (const bf16_t*)(p->ws + WS_VB);
    const bf16_t* O2 = (const bf16_t*)(p->ws + WS_O2);
    LAS float* scb = (LAS float*)lds;
    LAS float* qs = (LAS float*)(lds + 131072);
    LAS float* lrow = qs + 512;
    LAS float* red = lrow + 4;
    const size_t rowbase = (size_t)b * TSEQ;
    const int kend = 64 * (t0 / 64 + 1);
    const float slope2 = ldexpf(LOG2E, -(h + 1));
    { const int mm = tid >> 8, qi = (tid >> 6) & 3, d = tid & 63; qs[tid] = bf2f(Q[(rowbase + t0 + qi) * D + h * 128 + mm * 64 + d]); }
    __syncthreads();
    const int qi = tid >> 7, d = tid & 127;
    float res = 0.f;
    for (int mm = 0; mm < 2; ++mm) {
        for (int kk = tid; kk < kend; kk += 512) {
            const bf16_t* kp = KB + (rowbase + kk) * D + h * 128 + mm * 64;
            float dot[4] = {0.f, 0.f, 0.f, 0.f};
            for (int dd = 0; dd < 64; ++dd) { const float kv = bf2f(kp[dd]);
#pragma unroll
                for (int q = 0; q < 4; ++q) dot[q] += qs[(mm * 4 + q) * 64 + dd] * kv; }
#pragma unroll
            for (int q = 0; q < 4; ++q) scb[q * 8192 + kk] = dot[q] - slope2 * fabsf((float)(t0 + q - kk));
        }
        __syncthreads();
        if (wid < 4) {
            float mx = -3.0e38f;
            for (int kk = lane; kk < kend; kk += 64) mx = fmaxf(mx, scb[wid * 8192 + kk]);
            mx = wave_max(mx);
            float sum = 0.f;
            for (int kk = lane; kk < kend; kk += 64) { const float e = __builtin_amdgcn_exp2f(scb[wid * 8192 + kk] - mx); scb[wid * 8192 + kk] = e; sum += e; }
            sum = wave_sum(sum);
            if (lane == 0) lrow[wid] = sum;
        }
        __syncthreads();
        float acc = 0.f;
        for (int kk = 0; kk < kend; ++kk) acc += scb[qi * 8192 + kk] * bf2f(VB[(rowbase + kk) * D + h * 128 + d]);
        res += (mm == 0 ? 1.f : -lam) * acc / lrow[qi];
        __syncthreads();
    }
    { const float s = wave_sum(res * res); if (lane == 0) red[wid * 2] = s; }
    __syncthreads();
    const float tot = red[(2 * qi) * 2] + red[(2 * qi + 1) * 2];
    const float ref = res * rsqrtf(tot * (1.f / 128.f) + EPS) * p->in[I_SUBG][d] * 0.8f;
    const float fast = bf2f(O2[(rowbase + t0 + qi) * D + h * 128 + d]);
    __syncthreads();
    { const float e2 = wave_sum((fast - ref) * (fast - ref)), r2 = wave_sum(ref * ref); if (lane == 0) { red[wid * 2] = e2; red[wid * 2 + 1] = r2; } }
    __syncthreads();
    if (tid < 4) {
        const float e2 = red[(2 * tid) * 2] + red[(2 * tid + 1) * 2], r2 = red[(2 * tid) * 2 + 1] + red[(2 * tid + 1) * 2 + 1];
        const float rel = sqrtf(e2 / (r2 + 1e-30f));
        atomicMax((unsigned*)(p->ws + WS_DBG), __float_as_uint(rel));
        if (rel > 0.1f) atomicAdd((unsigned*)(p->ws + WS_DBG) + 1, 1u);
        atomicAdd((unsigned*)(p->ws + WS_DBG) + 2, 1u);
    }
    __syncthreads();
}
#endif

#ifdef SELFCHK4
__device__ __forceinline__ float chk_dot(const bf16_t* arow, const float* W, int ldw, int col, int K, int ln) {
    float s = 0.f;
    for (int k = ln; k < K; k += 64) s += bf2f(arow[k]) * W[(size_t)k * ldw + col];
    return wave_sum(s);
}
__device__ __forceinline__ void check_gemms(KP p, int which, int vcu, int G) {
    const int tid = tid_opaque(), ln = tid & 63, wv = tid >> 6;
    unsigned char* ws = p->ws; unsigned* dbg = (unsigned*)(ws + WS_END + 32768);
    const bf16_t* HNp = (const bf16_t*)(ws + (which == 0 ? WS_HN2 : WS_HN)); const bf16_t* GT = (const bf16_t*)(ws + WS_GATES);
    const bf16_t* OB = (const bf16_t*)(ws + WS_Q); const bf16_t* SB = (const bf16_t*)(ws + WS_U); const bf16_t* MX = (const bf16_t*)(ws + WS_MIXED);
    unsigned nb = 0, nt = 0;
    for (int it = 0; it < 32; ++it) {
#ifdef CHK4_ROWWISE
        const unsigned id = (unsigned)(vcu * 8 + wv);
        const unsigned hsh = id * 2654435761u;
        const int row = (int)(hsh >> 8) % CHK4_ROWS + CHK4_ROW0; const int col = (it * 32 + (int)(hsh & 31)) & 1023;
#else
        const unsigned id = (unsigned)((vcu * 8 + wv) * 32 + it);
        const unsigned hsh = id * 2654435761u;
        const int row = (int)(hsh >> 8) % CHK4_ROWS + CHK4_ROW0; const int col = (int)((hsh * 40503u) >> 12) & 1023;
#endif
        if (which == 0) {
#pragma unroll 1
            for (int hf = 0; hf < 2; ++hf) {
                const int c = col + 1024 * hf;
                const float z = chk_dot(HNp + (size_t)row * D, p->in[I_WGATE], 2048, c, D, ln) + p->in[I_BGATE][c];
                const size_t gi_ = (size_t)row * 2048 + c;
                const float ref = 1.f / (1.f + expf(-z)), got = bf2f(GT[gi_]);
                const unsigned wcoh = __hip_atomic_load((const unsigned*)(GT + (gi_ & ~(size_t)1)), __ATOMIC_RELAXED, __HIP_MEMORY_SCOPE_AGENT);
                const float gotc = (gi_ & 1) ? bf_hi(wcoh) : bf_lo(wcoh);
#if defined(CHK4_MODE) && CHK4_MODE == 1
                if (got != gotc) ++nb;
#elif defined(CHK4_MODE) && CHK4_MODE == 5
                if (fabsf(ref - gotc) > 0.02f && row < 32768) {
                    const float kold = bf2f(f2bf(p->out[O_KP + (size_t)(2 * row + hf) * D + col]));
                    if (gotc == kold) ++nb;
                }
#elif defined(CHK4_MODE) && CHK4_MODE == 4
                if (fabsf(ref - gotc) > 0.02f && fabsf(gotc) < 1e-6f) ++nb;
#elif defined(CHK4_MODE) && CHK4_MODE == 3
                if (fabsf(ref - gotc) > 0.02f && (gotc < 0.f || gotc > 1.f)) ++nb;
#elif defined(CHK4_MODE) && CHK4_MODE == 2
                if (fabsf(ref - gotc) > 0.02f) ++nb;
#else
                if (fabsf(ref - got) > 0.02f) ++nb;
#endif
                ++nt;
            }
        } else if (which == 2) {
            const bf16_t* HIDp = (const bf16_t*)(ws + WS_HID);
#pragma unroll 1
            for (int hf = 0; hf < 2; ++hf) {
                const int j = col + 1024 * hf;
                const float gg = chk_dot(HNp + (size_t)row * D, p->in[I_WGU1], 2 * DFF, j, D, ln), uu = chk_dot(HNp + (size_t)row * D, p->in[I_WGU1], 2 * DFF, DFF + j, D, ln);
                const float ref = gg / (1.f + expf(-gg)) * uu, got = bf2f(HIDp[(size_t)row * DFF + j]);
                if (fabsf(ref - got) > 0.03f * (fabsf(ref) + 0.3f)) ++nb;
                ++nt;
            }
        } else {
            const float a = chk_dot(OB + (size_t)row * D, p->in[I_WBR], D, col, D, ln), b = chk_dot(SB + (size_t)row * D, p->in[I_WBR] + (size_t)D * D, D, col, D, ln);
            const float ref = bf2f(GT[(size_t)row * 2048 + col]) * a + bf2f(GT[(size_t)row * 2048 + 1024 + col]) * b, got = bf2f(MX[(size_t)row * D + col]);
            if (fabsf(ref - got) > 0.03f * (fabsf(ref) + 0.3f)) ++nb;
            ++nt;
        }
    }
#ifdef CHK4_ROWWISE
    if (ln == 0) { atomicMax(dbg + 1 + 2 * which, nb); if (nb) atomicAdd(dbg + 9, 1u); }
#else
    if (ln == 0) { if (nb) atomicAdd(dbg + 1 + 2 * which, nb); atomicAdd(dbg + 2 + 2 * which, nt); }
#endif
    __syncthreads();
}
#endif
#ifndef MX_MASK
#define MX_MASK 15
#endif
#ifndef ATTN_REPS
#define ATTN_REPS 1
#endif
#ifndef UP_REPS
#define UP_REPS 1
#endif
#ifndef SP_REPS
#define SP_REPS 1
#endif
#ifndef SA_REPS
#define SA_REPS 1
#endif
#ifndef PRO_REPS
#define PRO_REPS 1
#endif
#ifndef NORM_REPS
#define NORM_REPS 1
#endif
__device__ __forceinline__ void mixer_phase(KP p, LAS unsigned char* lds, int vcu) {
    const int lane = tid_opaque() & 63;
    unsigned char* ws = p->ws;
    bf16_t* Q = (bf16_t*)(ws + WS_Q); const bf16_t* KB = (const bf16_t*)(ws + WS_KB); const bf16_t* VB = (const bf16_t*)(ws + WS_VB);
#if defined(SELFCHK) || defined(O_SEPARATE)
    bf16_t* OB = (bf16_t*)(ws + WS_O2);
#else
    bf16_t* OB = Q;
#endif
    bf16_t* U = (bf16_t*)(ws + WS_U); const bf16_t* GV = (const bf16_t*)(ws + WS_GV); const float* SSQ = (const float*)(ws + WS_SSQ);
    const float* lq = p->in[I_LQK];
    const float d1 = wave_sum(lq[lane] * lq[64 + lane]), d2 = wave_sum(lq[128 + lane] * lq[192 + lane]);
    const float lam = expf(d1) - expf(d2) + 0.2f;
    const float gqm = wave_max(fabsf(p->in[I_QG][lane])), gkm = wave_max(fabsf(p->in[I_KG][lane]));
    const float M2 = 8.f * gqm * gkm * 1.02f * LOG2E;
    if (MX_MASK & 1) { const int bh = vcu >> 2; for (int r_ = 0; r_ < SA_REPS; ++r_) sample_attn_unit(p, Q, (r_ + 1 < SA_REPS) ? (bf16_t*)(ws + 840 * MiB) : OB, bh >> 3, bh & 7, vcu & 3, lam, lds); }
    if ((MX_MASK & 2) && (vcu & 3) == 1 && (vcu >> 2) < 8) sample_spatial_unit(GV, U, SSQ, p->in[I_VNG], p->in[I_GWS], p->in[I_GBS], p->out + O_GS, vcu >> 2, lds);
    if (MX_MASK & 4) for (int r_ = 0; r_ < SP_REPS; ++r_) for (int ci = vcu; ci < MP / 128; ci += 256) spatial_unit(GV, U, SSQ, p->in[I_VNG], p->in[I_GWS], p->in[I_GBS], ci, lds, ws + WS_WF, p->ws + WS_END + 32768, (r_ + 1 < SP_REPS) ? (bf16_t*)(ws + 840 * MiB) : nullptr);
    __syncthreads();
    if (MX_MASK & 8) {
        const int b = vcu >> 5, pp = vcu & 31;
#pragma unroll 1
        for (int rep_ = 0; rep_ < ATTN_REPS; ++rep_)
#pragma unroll 1
        for (int h = 7; h >= 0; --h) {
            const float win = (2.f * M2 + 46.f) / ldexpf(LOG2E, -(h + 1));
            int ph = (pp + (int)((0x4a6d64a3dcULL >> (5 * h)) & 31)) & 31; if ((0x66 >> h) & 1) ph = 31 - ph;
            bf16_t* Od = (rep_ + 1 < ATTN_REPS) ? (bf16_t*)(ws + 840 * MiB) : OB;
            attn_unit(Q, KB, VB, Od, p->in[I_SUBG], b, h, 63 - ph, lds, lam, M2, win);
            attn_unit(Q, KB, VB, Od, p->in[I_SUBG], b, h, ph, lds, lam, M2, win);
        }
    }
}

#define RLX_AGENT __ATOMIC_RELAXED, __HIP_MEMORY_SCOPE_AGENT
#ifndef FENCE_SCOPE
#define FENCE_SCOPE ""
#endif
#define XB_TMO      128
#define XB_XCNT(j)  (256  + 64 * (j))
#define XB_XSUB(j)  (1280 + 64 * (j))
#define XB_XGEN(j)  (2304 + 64 * (j))
#define XB_TOP      3328
#define XB_TOPGEN   3392
#define XCD_BAR_WORDS 3456
#define XB_SPIN_CAP (1u << 18)

__device__ __forceinline__ unsigned xb_ld(unsigned* p)              { return __hip_atomic_load(p, __ATOMIC_RELAXED, __HIP_MEMORY_SCOPE_AGENT); }
__device__ __forceinline__ unsigned xb_add(unsigned* p, unsigned v) { return __hip_atomic_fetch_add(p, v, __ATOMIC_RELAXED, __HIP_MEMORY_SCOPE_AGENT); }
__device__ __forceinline__ unsigned xb_xcc_id() { return (unsigned)__builtin_amdgcn_s_getreg((3 << 11) | 20) & 0xFu; }
#define XB_SPIN(cond, bar) do { unsigned _sp = 0; while (cond) { __builtin_amdgcn_s_sleep(1); \
    if ((++_sp & 255u) == 0u) { if (xb_ld(&(bar)[XB_TMO])) break; if (_sp > XB_SPIN_CAP) { atomicAdd(&(bar)[XB_TMO], 1u); break; } } } } while (0)

struct XcdBarrier {
    unsigned* bar; unsigned x;
    volatile LAS unsigned* st;
};

__device__ __forceinline__ XcdBarrier xcd_barrier_post(unsigned* bar, volatile LAS unsigned* st) {
    XcdBarrier b; b.bar = bar; b.x = xb_xcc_id(); b.st = st;
    if (threadIdx.x == 0) (void)xb_add(&bar[XB_XCNT(b.x)], 1u);
    return b;
}
__device__ __forceinline__ void xcd_barrier_complete(unsigned* bar, unsigned x, unsigned& nloc, unsigned& nx) {
    const unsigned G = gridDim.x * gridDim.y * gridDim.z;
    unsigned sum, cnt, mine, sp = 0u;
    for (;;) {
        sum = 0u; cnt = 0u; mine = 0u;
#pragma unroll
        for (unsigned j = 0; j < 16; ++j) { const unsigned c = xb_ld(&bar[XB_XCNT(j)]); sum += c; cnt += (c > 0u) ? 1u : 0u; mine = (j == x) ? c : mine; }
        if (sum == G) break;
        __builtin_amdgcn_s_sleep(1);
        if ((++sp & 255u) == 0u) { if (xb_ld(&bar[XB_TMO])) break; if (sp > XB_SPIN_CAP) { atomicAdd(&bar[XB_TMO], 1u); break; } }
    }
    nloc = mine > 0u ? mine : 1u; nx = cnt > 0u ? cnt : 1u;
}

__device__ __forceinline__ void xcd_barrier(const XcdBarrier& b) {
    asm volatile("s_waitcnt vmcnt(0)" ::: "memory");
    __syncthreads();
    if (threadIdx.x == 0) {
        unsigned* bar = b.bar;
        __builtin_amdgcn_s_waitcnt(0);
        unsigned nloc = b.st[0], nx = b.st[1];
        if (nloc == 0u) { xcd_barrier_complete(bar, b.x, nloc, nx); b.st[0] = nloc; b.st[1] = nx; }
        const unsigned old = xb_add(&bar[XB_XSUB(b.x)], 1u);
        const unsigned gen = old / nloc;
        if (old + 1u == (gen + 1u) * nloc) {
            __builtin_amdgcn_fence(__ATOMIC_RELEASE, FENCE_SCOPE);
            asm volatile("s_waitcnt vmcnt(0)" ::: "memory");
            const unsigned og = xb_add(&bar[XB_TOP], 1u);
            const unsigned tg = og / nx;
            if (og + 1u == (tg + 1u) * nx) xb_add(&bar[XB_TOPGEN], 1u);
            else XB_SPIN(xb_ld(&bar[XB_TOPGEN]) == tg, bar);
            __builtin_amdgcn_fence(__ATOMIC_ACQUIRE, FENCE_SCOPE);
            xb_add(&bar[XB_XGEN(b.x)], 1u);
            asm volatile("s_waitcnt vmcnt(0)" ::: "memory");
        } else {
            XB_SPIN(xb_ld(&bar[XB_XGEN(b.x)]) == gen, bar);
            __builtin_amdgcn_fence(__ATOMIC_ACQUIRE, FENCE_SCOPE);
            asm volatile("s_waitcnt vmcnt(0)" ::: "memory");
        }
    }
    __syncthreads();
}

constexpr size_t WS_BAR = WS_END;
constexpr size_t WS_BAR_BYTES = 65536, WS_TOTAL = WS_BAR + WS_BAR_BYTES;
constexpr int LDS_XB = 139264;
__device__ __forceinline__ void seam_barrier(const XcdBarrier& b) {
#ifdef HEAVY_SEAM
    asm volatile("s_waitcnt vmcnt(0)\n\tbuffer_wbl2 sc0 sc1\n\ts_waitcnt vmcnt(0)\n\tbuffer_inv sc0 sc1\n\ts_waitcnt vmcnt(0)" ::: "memory");
#endif
    xcd_barrier(b);
#ifdef HEAVY_SEAM
    asm volatile("buffer_inv sc0 sc1\n\ts_waitcnt vmcnt(0)" ::: "memory");
    __syncthreads();
#endif
}
__device__ __forceinline__ void grid_barrier(cg::grid_group& grid) {
    asm volatile("s_waitcnt vmcnt(0)" ::: "memory");
    __syncthreads();
    if (threadIdx.x < 64) { __builtin_amdgcn_fence(__ATOMIC_RELEASE, FENCE_SCOPE); asm volatile("s_waitcnt vmcnt(0)" ::: "memory"); }
    grid.sync();
    __builtin_amdgcn_fence(__ATOMIC_ACQUIRE, FENCE_SCOPE);
    asm volatile("s_waitcnt vmcnt(0)" ::: "memory");
}
#if defined(SELFCHK) || defined(O_SEPARATE)
constexpr size_t WS_OSRC = WS_O2;
#else
constexpr size_t WS_OSRC = WS_Q;
#endif
#ifndef PH_MASK
#define PH_MASK 0xFFFF
#endif
#ifndef CHK_ITERS
#define CHK_ITERS 4
#endif
#ifndef CHK5_M0
#define CHK5_M0 0
#define CHK5_M1 6
#endif
#ifndef CHK4_REPORT
#define CHK4_REPORT (1000.f * (1.f + (float)nbad / 16.f))
#endif
#ifndef CHK4_ROWS
#define CHK4_ROWS MP
#endif
#ifndef CHK4_ROW0
#define CHK4_ROW0 0
#endif
#ifndef CHK4_WHICH
#define CHK4_WHICH 0
#endif
#ifndef CHK3_ROWS
#define CHK3_ROWS MP
#endif
#ifndef CHK_ATT_ITERS
#define CHK_ATT_ITERS CHK_ITERS
#endif
#ifndef CHK_REPORT
#define CHK_REPORT (1000.f + 100000.f * (float)nbad / (float)(ntot + 1))
#endif
#ifndef CHK_OFF
#define CHK_OFF(o) ((o) & 60)
#endif
#ifndef CHK_FILTER
#define CHK_FILTER
#endif
#ifndef STEP_LIMIT
#define STEP_LIMIT 13
#endif
__global__ void __launch_bounds__(512, 2) fwd_megakernel(Params p_unused) {
    extern __shared__ __attribute__((aligned(16))) unsigned char lds_raw[];
    LAS unsigned char* lds = (LAS unsigned char*)lds_raw;
    cg::grid_group grid = cg::this_grid();
    if (threadIdx.x < 2) ((volatile LAS unsigned*)(lds + LDS_XB))[threadIdx.x] = 0u;
    __syncthreads();
    const XcdBarrier xbar = xcd_barrier_post((unsigned*)(kparams()->ws + WS_BAR), (volatile LAS unsigned*)(lds + LDS_XB));
    grid.sync();
    const int G0 = gridDim.x, bx0 = blockIdx.x;
    const int vcu0 = (G0 % 8 == 0) ? (bx0 % 8) * (G0 / 8) + bx0 / 8 : bx0;
#pragma unroll 1
    for (int step = 0; step < 14; ++step) {
        const KP kp = kparams();
        if (step > STEP_LIMIT && step != 13) { seam_barrier(xbar); continue; }
        int G = G0, bx = bx0, vcu = vcu0; asm volatile("" : "+s"(G), "+s"(bx), "+s"(vcu));
        if (step == 0 && (PH_MASK & 1)) {
            for (int r_ = 0; r_ < PRO_REPS; ++r_) { prologue(kp, lds, vcu, G); __syncthreads(); }
        } else if ((step == 1 || step == 4 || step == 10 || step == 13) && (PH_MASK & 2)) {
            for (int r_ = 0; r_ < ((step == 13) ? 1 : NORM_REPS); ++r_) norm_rows(kp, step == 1 ? 0 : step == 4 ? 1 : step == 10 ? 2 : 3, vcu, G);
        } else if ((step == 2 || step == 11) && (PH_MASK & 4)) {
#pragma unroll 1
            for (int part = 0; part < 2 * UP_REPS; ++part) {
                unsigned char* ws = kp->ws; const int roff = (part & 1) ? MP : 0;
                pg8::Gemm g{(const bf16_t*)(ws + WS_HN) + (size_t)roff * D, (const bf16_t*)(ws + (step == 2 ? WS_WGU1 : WS_WGU2)), (part & 1) ? 256 : MP, 2 * DFF, D};
                pg8::StaticOrder S; S.init((part & 1) ? 256 : MP, 2 * DFF, G, bx);
                EpiUp E{kp, roff};
                pg8::gemm_phase<EpiUp, pg8::StaticOrder, true, true>(lds, g, S, E);
            }
#ifdef SELFCHK4
            if (step == 2) { seam_barrier(xbar); check_gemms(kp, 2, vcu, G); }
#endif
#ifdef SELFCHK5
            if (step == SELFCHK5) {
                seam_barrier(xbar);
                unsigned char* ws5 = kp->ws; unsigned nb5 = 0; const int t5 = tid_opaque();
                const float* srcs[6] = {kp->in[I_WGATE], kp->in[I_WBR], kp->in[I_WBR] + (size_t)D * D, kp->in[I_WOUT], kp->in[I_WD1], kp->in[I_WD2]};
                const size_t offs[6] = {WS_WGT, WS_WBA, WS_WBB, WS_WOUT, WS_WD1, WS_WD2};
                const int Ns[6] = {2048, D, D, D, D, D}, Ks[6] = {D, D, D, D, DFF, DFF};
                for (int mi = CHK5_M0; mi < CHK5_M1; ++mi) {
                    const bf16_t* WT = (const bf16_t*)(ws5 + offs[mi]); const float* W = srcs[mi]; const int N5 = Ns[mi], K5 = Ks[mi];
                    for (size_t e = (size_t)vcu * 512 + t5; e < (size_t)N5 * K5; e += (size_t)G * 512) {
                        const int n = (int)(e / K5), k = (int)(e % K5);
                        if (WT[e] != f2bf(W[(size_t)k * N5 + n])) ++nb5;
                    }
                }
                if (nb5) atomicAdd((unsigned*)(ws5 + WS_END + 32768) + 1, nb5);
                __syncthreads();
            }
#endif
        } else if ((step == 3 || step == 12 || step == 9) && (PH_MASK & 8)) {
#pragma unroll 1
            for (int part = 0; part < 2; ++part) {
                unsigned char* ws = kp->ws; const int roff = part ? MP : 0; const int K = step == 9 ? D : DFF;
                pg8::Gemm g{(const bf16_t*)(ws + (step == 9 ? WS_MIXED : WS_HID)) + (size_t)roff * K, (const bf16_t*)(ws + (step == 3 ? WS_WD1 : step == 12 ? WS_WD2 : WS_WOUT)), part ? 256 : MP, D, K};
                pg8::StaticOrder S; S.init(part ? 256 : MP, D, G, bx);
                EpiRes E{kp, step == 3 ? 2 : step == 9 ? 5 : 8, step == 9 ? 1.f : 0.5f, step == 3 ? 1 : 0, roff};
                pg8::gemm_phase<EpiRes, pg8::StaticOrder, true, true>(lds, g, S, E);
            }
        } else if (step == 5 && (PH_MASK & 16)) {
#pragma unroll 1
            for (int part = 0; part < 2; ++part) {
                unsigned char* ws = kp->ws; const int roff = part ? MP : 0;
                pg8::Gemm g{(const bf16_t*)(ws + WS_HN2) + (size_t)roff * D, (const bf16_t*)(ws + WS_WIN), part ? 256 : MP, 5120, D};
                pg8::StaticOrder S; S.init(part ? 256 : MP, 5120, G, bx);
                EpiIn E{kp, roff};
                pg8::gemm_phase<EpiIn, pg8::StaticOrder, true, true>(lds, g, S, E);
            }
        } else if (step == 6 && (PH_MASK & 32)) {
            mixer_phase(kp, lds, vcu);
        } else if (step == 7 && (PH_MASK & 64)) {
#ifdef SELFCHK3
            {
                const bf16_t* OB = (const bf16_t*)(kp->ws + WS_Q); const int tid3 = tid_opaque(), ln = tid3 & 63, wv = tid3 >> 6;
                unsigned nb = 0;
                for (int row = vcu * 8 + wv; row < CHK3_ROWS; row += G * 8) {
                    for (int hh = 0; hh < 8; ++hh) {
                        const unsigned w = *(const unsigned*)(OB + (size_t)row * D + hh * 128 + 2 * ln);
                        const float a = bf_lo(w), b = bf_hi(w);
                        const float ms = wave_sum(a * a + b * b) * (1.f / 128.f);
                        if (!(ms > 0.3f && ms < 1.2f)) ++nb;
                    }
                }
                if (ln == 0 && nb) atomicAdd((unsigned*)(kp->ws + WS_END + 32768) + 1, nb);
                __syncthreads();
                seam_barrier(xbar);
            }
#endif
#pragma unroll 1
            for (int part = 0; part < 2; ++part) {
                unsigned char* ws = kp->ws; const int roff = part ? MP : 0;
                pg8::Gemm g{(const bf16_t*)(ws + WS_HN2) + (size_t)roff * D, (const bf16_t*)(ws + WS_WGT), part ? 256 : MP, 2048, D};
                pg8::StaticOrder S; S.init(part ? 256 : MP, 2048, G, bx);
                EpiGates E{kp, roff};
                pg8::gemm_phase<EpiGates, pg8::StaticOrder, true, true>(lds, g, S, E);
            }
#ifdef SELFCHK4
            seam_barrier(xbar); check_gemms(kp, 0, vcu, G);
#endif
        } else if (step == 8 && (PH_MASK & 128)) {
#pragma unroll 1
            for (int hp = 0; hp < 4; ++hp) {
                const int half = hp & 1, part = hp >> 1;
                unsigned char* ws = kp->ws; const int roff = part ? MP : 0;
                pg8::Gemm g{(const bf16_t*)(ws + (half ? WS_U : WS_Q)) + (size_t)roff * D, (const bf16_t*)(ws + (half ? WS_WBB : WS_WBA)), part ? 256 : MP, D, D};
                pg8::StaticOrder S; S.init(part ? 256 : MP, D, G, bx);
                EpiBr E{kp, half * D, half, roff};
                pg8::gemm_phase<EpiBr, pg8::StaticOrder, true, true>(lds, g, S, E);
            }
#ifdef SELFCHK4
            seam_barrier(xbar); check_gemms(kp, 1, vcu, G);
#endif
        }
#if defined(SELFCHK4) || defined(SELFCHK5)
        if (step == 13 && bx0 == 0 && threadIdx.x == 0) { unsigned* dbg = (unsigned*)(kp->ws + WS_END + 32768); const unsigned nbad = __hip_atomic_load(dbg + 1 + 2 * CHK4_WHICH, __ATOMIC_RELAXED, __HIP_MEMORY_SCOPE_AGENT); kp->out[1] = CHK4_REPORT; }
#endif
#ifdef SELFCHK3
        if (step == 13 && bx0 == 0 && threadIdx.x == 0) { const unsigned nbad = __hip_atomic_load((unsigned*)(kp->ws + WS_END + 32768) + 1, __ATOMIC_RELAXED, __HIP_MEMORY_SCOPE_AGENT); kp->out[1] = 1000.f * (1.f + (float)nbad / 16.f); }
#endif
#ifdef SELFCHK
        if (step == 13 && bx0 == 0 && threadIdx.x == 0) { const float rel = __uint_as_float(__hip_atomic_load((unsigned*)(kp->ws + WS_DBG), __ATOMIC_RELAXED, __HIP_MEMORY_SCOPE_AGENT)); const unsigned nbad = __hip_atomic_load((unsigned*)(kp->ws + WS_DBG) + 1, __ATOMIC_RELAXED, __HIP_MEMORY_SCOPE_AGENT), ntot = __hip_atomic_load((unsigned*)(kp->ws + WS_DBG) + 2, __ATOMIC_RELAXED, __HIP_MEMORY_SCOPE_AGENT);
            kp->out[1] = CHK_REPORT; }
#endif
        if (step < 13) seam_barrier(xbar);
    }
}

extern "C" void kernel_launch(void* const* d_in, const int* in_sizes, int n_in, void* d_out, int out_size, void* d_ws, size_t ws_size, hipStream_t stream) {
    static int grid = 0;
    if (grid == 0) {
        if (n_in != 25 || (size_t)out_size != O_END || ws_size < WS_TOTAL) { fprintf(stderr, "kernel_launch: unexpected shapes (n_in %d out %d ws %zu)\n", n_in, out_size, ws_size); grid = -1; return; }
        int dev = 0, cus = 0, per_cu = 0;
        hipGetDevice(&dev);
        hipDeviceGetAttribute(&cus, hipDeviceAttributeMultiprocessorCount, dev);
        if (hipFuncSetAttribute((const void*)fwd_megakernel, hipFuncAttributeMaxDynamicSharedMemorySize, LDS_BYTES) != hipSuccess) { fprintf(stderr, "kernel_launch: hipFuncSetAttribute failed\n"); grid = -1; return; }
        if (hipOccupancyMaxActiveBlocksPerMultiprocessor(&per_cu, (const void*)fwd_megakernel, 512, LDS_BYTES) != hipSuccess || per_cu < 1) { fprintf(stderr, "kernel_launch: occupancy query says %d\n", per_cu); per_cu = 1; }
        (void)hipGetLastError();
        grid = cus * per_cu;
    }
    if (grid < 0) return;
    if (hipMemsetAsync((char*)d_ws + WS_BAR, 0, WS_BAR_BYTES, stream) != hipSuccess) { fprintf(stderr, "kernel_launch: memset failed\n"); return; }
    Params p{};
    for (int i = 0; i < 25; ++i) p.in[i] = (const float*)d_in[i];
    p.out = (float*)d_out; p.ws = (unsigned char*)d_ws;
    void* args[] = {&p};
    hipError_t e = hipLaunchCooperativeKernel((const void*)fwd_megakernel, dim3(grid), dim3(512), args, LDS_BYTES, stream);
    if (e != hipSuccess) fprintf(stderr, "cooperative launch failed: %s (grid %d)\n", hipGetErrorString(e), grid);
}
```

```cpp
#include <hip/hip_runtime.h>
#include <hip/hip_cooperative_groups.h>
#include <cstdio>
#include <cstdint>
namespace cg = cooperative_groups;
namespace pg8 {
#define PG8_LAS __attribute__((address_space(3)))
typedef unsigned short bf16_t;
typedef short bf16x8 __attribute__((ext_vector_type(8)));
typedef float f32x4 __attribute__((ext_vector_type(4)));
typedef unsigned u32x4 __attribute__((ext_vector_type(4)));
constexpr int BM = 256, BK = 64, HALF = 128, HTB = HALF * BK * 2  , STAGE_BYTES = 8 * HTB, NXCD = 8, WGM = 8;

__host__ __device__ __forceinline__ int lds_byte(int r, int c) { const int st = (r >> 4) * 2 + (c >> 5), rr = r & 15, cc = c & 31, ob = rr * 64 + cc * 2; return st * 1024 + (ob ^ (((ob >> 9) & 1) << 5)); }
__host__ __device__ __forceinline__ void stage_rc(int b, int& R, int& C) { const int st = b / 1024, sb = b % 1024, swz = sb ^ (((sb >> 9) & 1) << 5); R = (st >> 1) * 16 + swz / 64; C = (st & 1) * 32 + (swz % 64) / 2; }
__host__ __device__ __forceinline__ int perm32(int rho) { const int n = rho >> 4, i = rho & 15; return 8 * (i >> 2) + 4 * n + (i & 3); }

struct Unit { int pm, pn; };
struct Gemm { const bf16_t* A; const bf16_t* Bt; int M, N, K; };

struct StaticOrder {
    int nM, nN, nwg, G, c;
    __host__ __device__ void init(int M, int N, int G_, int c_) { nM = M / BM; nN = N / BM; nwg = nM * nN; G = G_; c = c_; }
    __host__ __device__ bool next(int i, Unit& u) const {
        const long L = (long)i * G + c; if (L >= nwg) return false;
        int wgid = (int)L; { const int q = nwg / NXCD, r = nwg % NXCD, xcd = wgid % NXCD, off = wgid / NXCD; wgid = (xcd < r ? xcd * (q + 1) : r * (q + 1) + (xcd - r) * q) + off; }
        const int nig = WGM * nN, gid = wgid / nig, fm = gid * WGM, gsz = (nM - fm) < WGM ? (nM - fm) : WGM;
        u.pm = fm + ((wgid % nig) % gsz); u.pn = (wgid % nig) / gsz; return true;
    }
    __device__ __forceinline__ void a_ready(const Unit&) const {}
    __device__ __forceinline__ void done(const Unit&) const {}
};
__device__ __forceinline__ unsigned cvt_pk_bf16(float lo, float hi) { unsigned r; asm volatile("v_cvt_pk_bf16_f32 %0, %1, %2" : "=v"(r) : "v"(lo), "v"(hi)); return r; }
template <class Epi, class Sched, bool ALIGN_EPI = false, bool SP2 = false, bool HALF_M = false>
__device__ __forceinline__ void gemm_phase(PG8_LAS unsigned char* lds, const Gemm g, const Sched& S, const Epi& E) {
    int tid_ = threadIdx.x; asm volatile("" : "+v"(tid_));
    const int tid = tid_, wid = __builtin_amdgcn_readfirstlane(tid >> 6), lane = tid & 63, wr = wid >> 2, wc = wid & 3, fr = lane & 15, fq = lane >> 4;
    const int K = g.K, nt = K / BK;
    unsigned voffA[2], voffB[2];
#pragma unroll
    for (int i = 0; i < 2; ++i) { int R, C; stage_rc(tid * 16 + i * 8192, R, C); const int Rb = Epi::PERM ? ((R & ~31) + perm32(R & 31)) : R;
        voffA[i] = (unsigned)(R * K + C) * 2u; voffB[i] = (unsigned)(Rb * K + C) * 2u; }
    const size_t kstep = (size_t)(BK * 2);
    const size_t hstep = (size_t)HALF * K * 2;
    const size_t tstep = 2 * hstep;
    const unsigned ldsw = (unsigned)wid * 1024u;
    const int aoff = lds_byte(wr * 64 + fr, fq * 8), boff = lds_byte(wc * 32 + fr, fq * 8);
#define PG8_SA(b, h) (((b) * 2 + (h)) * HTB)
#define PG8_SB(b, h) ((4 + (b) * 2 + (h)) * HTB)
#define PG8_STAGE(bufoff, gbase, voff) do { _Pragma("unroll") for (int _i = 0; _i < 2; ++_i) \
        __builtin_amdgcn_global_load_lds((const unsigned*)((const char*)(gbase) + (voff)[_i]), (PG8_LAS unsigned*)(lds + (bufoff) + ldsw + _i * 8192), 16, 0, 0); } while (0)
#define PG8_LDA(dst, b, h) do { _Pragma("unroll") for (int m = 0; m < 4; ++m) _Pragma("unroll") for (int k = 0; k < 2; ++k) dst[m][k] = *(const PG8_LAS bf16x8*)(lds + PG8_SA(b, h) + aoff + m * 2048 + k * 1024); } while (0)
#define PG8_LDB(dst, b, h) do { _Pragma("unroll") for (int n = 0; n < 2; ++n) _Pragma("unroll") for (int k = 0; k < 2; ++k) dst[n][k] = *(const PG8_LAS bf16x8*)(lds + PG8_SB(b, h) + boff + n * 2048 + k * 1024); } while (0)
#define PG8_MMA(ai, bj, At, Bt) do { __builtin_amdgcn_s_setprio(1); _Pragma("unroll") for (int m = 0; m < 4; ++m) _Pragma("unroll") for (int n = 0; n < 2; ++n) _Pragma("unroll") for (int k = 0; k < 2; ++k) \
        acc[ai][bj][m][n] = __builtin_amdgcn_mfma_f32_16x16x32_bf16(Bt[n][k], At[m][k], acc[ai][bj][m][n], 0, 0, 0); __builtin_amdgcn_s_setprio(0); } while (0)
#define PG8_WAIT_V(n) asm volatile("s_waitcnt vmcnt(" #n ")" ::: "memory")
#define PG8_WAIT_L(n) asm volatile("s_waitcnt lgkmcnt(" #n ")" ::: "memory")
#define PG8_BAR __builtin_amdgcn_s_barrier()
#define PG8_SCHED __builtin_amdgcn_sched_barrier(0)
    Unit cur, nxt; int ui = 0;
    if (!S.next(0, cur)) return;
    f32x4 acc[2][2][4][2];
#pragma unroll
    for (int a = 0; a < 2; ++a)
#pragma unroll
        for (int b = 0; b < 2; ++b)
#pragma unroll
            for (int m = 0; m < 4; ++m)
#pragma unroll
                for (int n = 0; n < 2; ++n) acc[a][b][m][n] = (f32x4){0.f, 0.f, 0.f, 0.f};
    bf16x8 At[4][2], B0[2][2], B1[2][2];
    const char* cA = (const char*)g.A + (size_t)cur.pm * tstep; const char* cB = (const char*)g.Bt + (size_t)cur.pn * tstep;
    S.a_ready(cur);
    if constexpr (SP2) {
        PG8_STAGE(PG8_SB(0, 0), cB, voffB); PG8_STAGE(PG8_SB(0, 1), cB + hstep, voffB); PG8_STAGE(PG8_SA(0, 0), cA, voffA); PG8_STAGE(PG8_SA(0, 1), cA + hstep, voffA);
        if (wr == 1) PG8_BAR;
        PG8_WAIT_V(2); PG8_BAR;
        PG8_STAGE(PG8_SB(1, 0), cB + kstep, voffB); PG8_STAGE(PG8_SA(1, 0), cA + kstep, voffA); PG8_STAGE(PG8_SB(1, 1), cB + hstep + kstep, voffB);
        PG8_WAIT_V(6); PG8_BAR;
    } else {
        PG8_STAGE(PG8_SB(0, 0), cB, voffB); PG8_STAGE(PG8_SA(0, 0), cA, voffA); PG8_STAGE(PG8_SB(0, 1), cB + hstep, voffB); PG8_STAGE(PG8_SA(0, 1), cA + hstep, voffA);
        if (wr == 1) PG8_BAR;
        PG8_WAIT_V(4); PG8_BAR;
        PG8_STAGE(PG8_SB(1, 0), cB + kstep, voffB); PG8_STAGE(PG8_SA(1, 0), cA + kstep, voffA); PG8_STAGE(PG8_SB(1, 1), cB + hstep + kstep, voffB);
        PG8_WAIT_V(6); PG8_BAR;
    }
    for (;;) {
        const bool has_next = S.next(ui + 1, nxt);
        const char* nA = has_next ? (const char*)g.A + (size_t)nxt.pm * tstep : cA; const char* nB = has_next ? (const char*)g.Bt + (size_t)nxt.pn * tstep : cB;
        for (int t = 0; t < nt; t += 2) {
            const bool last = (t == nt - 2);
            const char* a1 = cA + (size_t)(t + 1) * kstep;
            const char* a2 = last ? nA : cA + (size_t)(t + 2) * kstep; const char* b2 = last ? nB : cB + (size_t)(t + 2) * kstep;
            const char* a3 = a2 + kstep; const char* b3 = b2 + kstep;
            if (last && has_next) S.a_ready(nxt);
            if constexpr (SP2) {
            PG8_LDB(B0, 0, 0); PG8_LDB(B1, 0, 1); PG8_SCHED; PG8_LDA(At, 0, 0); PG8_STAGE(PG8_SA(1, 1), a1 + hstep, voffA);
            PG8_WAIT_V(8); PG8_WAIT_L(0); PG8_BAR; PG8_MMA(0, 0, At, B0); PG8_MMA(0, 1, At, B1); PG8_BAR; PG8_SCHED;
            if constexpr (!HALF_M) { PG8_LDA(At, 0, 1); } PG8_STAGE(PG8_SB(0, 0), b2, voffB); PG8_STAGE(PG8_SB(0, 1), b2 + hstep, voffB); PG8_STAGE(PG8_SA(0, 0), a2, voffA);
            PG8_WAIT_V(8); PG8_WAIT_L(0); PG8_BAR; if constexpr (!HALF_M) { PG8_MMA(1, 0, At, B0); PG8_MMA(1, 1, At, B1); } PG8_BAR; PG8_SCHED;
            PG8_LDB(B0, 1, 0); PG8_LDB(B1, 1, 1); PG8_SCHED; PG8_LDA(At, 1, 0); PG8_STAGE(PG8_SA(0, 1), a2 + hstep, voffA);
            PG8_WAIT_V(8); PG8_WAIT_L(0); PG8_BAR; PG8_MMA(0, 0, At, B0); PG8_MMA(0, 1, At, B1); PG8_BAR; PG8_SCHED;
            if constexpr (!HALF_M) { PG8_LDA(At, 1, 1); } PG8_STAGE(PG8_SB(1, 0), b3, voffB); PG8_STAGE(PG8_SB(1, 1), b3 + hstep, voffB); PG8_STAGE(PG8_SA(1, 0), a3, voffA);
            PG8_WAIT_V(8); PG8_WAIT_L(0); PG8_BAR; if constexpr (!HALF_M) { PG8_MMA(1, 0, At, B0); PG8_MMA(1, 1, At, B1); } PG8_BAR; PG8_SCHED;
            } else {
            PG8_LDB(B0, 0, 0); PG8_SCHED; PG8_LDA(At, 0, 0); PG8_STAGE(PG8_SA(1, 1), a1 + hstep, voffA);
            PG8_WAIT_L(8); PG8_BAR; PG8_WAIT_L(0); PG8_MMA(0, 0, At, B0); PG8_BAR; PG8_SCHED;
            PG8_LDB(B1, 0, 1); PG8_STAGE(PG8_SB(0, 0), b2, voffB);
            PG8_BAR; PG8_WAIT_L(0); PG8_MMA(0, 1, At, B1); PG8_BAR;
            PG8_LDA(At, 0, 1); PG8_STAGE(PG8_SA(0, 0), a2, voffA);
            PG8_BAR; PG8_WAIT_L(0); PG8_MMA(1, 0, At, B0); PG8_BAR; PG8_SCHED;
            PG8_STAGE(PG8_SB(0, 1), b2 + hstep, voffB);
            PG8_WAIT_V(6); PG8_BAR; PG8_MMA(1, 1, At, B1); PG8_BAR;
            PG8_LDB(B0, 1, 0); PG8_SCHED; PG8_LDA(At, 1, 0); PG8_STAGE(PG8_SA(0, 1), a2 + hstep, voffA);
            PG8_WAIT_L(8); PG8_BAR; PG8_WAIT_L(0); PG8_MMA(0, 0, At, B0); PG8_BAR; PG8_SCHED;
            PG8_LDB(B1, 1, 1); PG8_STAGE(PG8_SB(1, 0), b3, voffB);
            PG8_BAR; PG8_WAIT_L(0); PG8_MMA(0, 1, At, B1); PG8_BAR;
            PG8_LDA(At, 1, 1); PG8_STAGE(PG8_SA(1, 0), a3, voffA);
            PG8_BAR; PG8_WAIT_L(0); PG8_MMA(1, 0, At, B0); PG8_BAR; PG8_SCHED;
            PG8_STAGE(PG8_SB(1, 1), b3 + hstep, voffB);
            PG8_WAIT_V(6); PG8_BAR; PG8_MMA(1, 1, At, B1); PG8_BAR;
            }
        }
        if constexpr (ALIGN_EPI) { if (wr == 0) PG8_BAR; }
        if constexpr (!Epi::AFTER_DRAIN) { E(acc, cur, wr, wc, fr, fq); S.done(cur); }
        if (!has_next) break;
#pragma unroll
        for (int a = 0; a < 2; ++a)
#pragma unroll
            for (int b = 0; b < 2; ++b)
#pragma unroll
                for (int m = 0; m < 4; ++m)
#pragma unroll
                    for (int n = 0; n < 2; ++n) acc[a][b][m][n] = (f32x4){0.f, 0.f, 0.f, 0.f};
        cur = nxt; cA = nA; cB = nB; ++ui;
        if constexpr (ALIGN_EPI) { if (wr == 1) PG8_BAR; }
    }
    PG8_WAIT_V(0);
    if constexpr (!ALIGN_EPI) { if (wr == 0) PG8_BAR; }
    PG8_BAR;
    if constexpr (Epi::AFTER_DRAIN) { E.fused(acc, cur, wr, wc, fr, fq, lds, wid, lane); S.done(cur); }
#undef PG8_SA
#undef PG8_SB
#undef PG8_STAGE
#undef PG8_LDA
#undef PG8_LDB
#undef PG8_MMA
#undef PG8_WAIT_V
#undef PG8_WAIT_L
#undef PG8_BAR
#undef PG8_SCHED
}
}

using pg8::bf16_t; using pg8::f32x4; using pg8::u32x4; using pg8::bf16x8;
typedef float f32x16 __attribute__((ext_vector_type(16)));
typedef short v4i16_t __attribute__((ext_vector_type(4)));
typedef unsigned u32x2 __attribute__((ext_vector_type(2)));
#define LAS __attribute__((address_space(3)))

constexpr int D = 1024, MP = 65536, MS = 128, MV = MP + MS, MT = 65792, DFF = 2816, TSEQ = 8192, NMOD = 9216;
constexpr float EPS = 1e-6f, LOG2E = 1.4426950408889634f;
constexpr size_t MiB = 1ull << 20;
constexpr size_t WS_WGU1 = 0, WS_WD1 = 11 * MiB, WS_WIN = 17 * MiB, WS_WGT = 27 * MiB, WS_WBA = 31 * MiB, WS_WBB = 33 * MiB,
                 WS_WOUT = 35 * MiB, WS_WGU2 = 37 * MiB, WS_WD2 = 48 * MiB, WS_MODS = 54 * MiB, WS_SSQ = 55 * MiB, WS_HN = 60 * MiB,
                 WS_R = 189 * MiB, WS_Q = WS_R, WS_KB = WS_R + 129 * MiB, WS_VB = WS_R + 258 * MiB, WS_U = WS_R + 387 * MiB,
                 WS_GV = WS_R + 516 * MiB, WS_END = WS_R + 645 * MiB;
constexpr size_t WS_HID = WS_R, WS_GATES = WS_KB, WS_MIXED = WS_GV;
constexpr size_t WS_WF = 59 * MiB + 65536;
static_assert(WS_SSQ + (size_t)16 * MT * 4 <= WS_WF && WS_WF + 8 * 4 * 8 * 64 * 16 <= WS_HN, "Wf slot");
#ifdef SEP_HN2
constexpr size_t WS_HN2 = 840 * MiB;
#else
constexpr size_t WS_HN2 = WS_HN;
#endif
static_assert((size_t)MT * D * 2 <= 129 * MiB && (size_t)MT * DFF * 2 <= 645 * MiB && (size_t)MT * 2048 * 2 <= 258 * MiB, "ws map");
constexpr size_t O_Y = 0, O_KP = (size_t)MV * D, O_VP = O_KP + (size_t)MP * D, O_KS = O_VP + (size_t)MP * D, O_VS = O_KS + (size_t)MS * D,
                 O_GS = O_VS + (size_t)MS * D, O_END = O_GS + (size_t)MS * D;
constexpr int LDS_BYTES = 139264 + 256;

struct Params { const float* in[25]; float* out; unsigned char* ws; };
typedef const __attribute__((address_space(4))) Params* KP;
__device__ __forceinline__ KP kparams() { KP k = (KP)__builtin_amdgcn_kernarg_segment_ptr(); asm volatile("" : "+s"(k)); return k; }
enum { I_XP = 0, I_XS, I_CK, I_CV, I_CP, I_CS, I_ADAW, I_ADAB, I_NORMG, I_WGU1, I_WD1, I_WIN, I_QG, I_KG, I_LQK, I_SUBG, I_VNG, I_GWS, I_GBS,
       I_WGATE, I_BGATE, I_WBR, I_WOUT, I_WGU2, I_WD2 };

typedef float f32x2_t __attribute__((ext_vector_type(2))); typedef __bf16 bf16x2_t __attribute__((ext_vector_type(2)));
__device__ __forceinline__ unsigned cvt_pk(float lo, float hi) { f32x2_t v = {lo, hi}; bf16x2_t b = __builtin_convertvector(v, bf16x2_t); return __builtin_bit_cast(unsigned, b); }
__device__ __forceinline__ u32x4 pack8(f32x4 a, f32x4 b) { u32x4 w; w.x = cvt_pk(a[0], a[1]); w.y = cvt_pk(a[2], a[3]); w.z = cvt_pk(b[0], b[1]); w.w = cvt_pk(b[2], b[3]); return w; }
__device__ __forceinline__ float bf_lo(unsigned w) { return __uint_as_float(w << 16); }
__device__ __forceinline__ float bf_hi(unsigned w) { return __uint_as_float(w & 0xffff0000u); }
__device__ __forceinline__ float bf2f(bf16_t h) { return __uint_as_float((unsigned)h << 16); }
__device__ __forceinline__ bf16_t f2bf(float f) { return (bf16_t)(cvt_pk(f, 0.f) & 0xffffu); }
__device__ __forceinline__ float fast_rcp(float x) { return __builtin_amdgcn_rcpf(x); }
__device__ __forceinline__ float sigmoidf_(float x) { return fast_rcp(1.f + __builtin_amdgcn_exp2f(-x * LOG2E)); }
__device__ __forceinline__ float siluf_(float x) { return x * sigmoidf_(x); }
__device__ __forceinline__ float geluf_(float x) { const float y = 0.7978845608028654f * (x + 0.044715f * x * x * x); return x * sigmoidf_(2.f * y); }
__device__ __forceinline__ f32x4 gelu4(f32x4 v) { return (f32x4){geluf_(v[0]), geluf_(v[1]), geluf_(v[2]), geluf_(v[3])}; }
__device__ __forceinline__ float wave_sum(float v) {
#pragma unroll
    for (int o = 1; o < 64; o <<= 1) v += __shfl_xor(v, o);
    return v;
}
__device__ __forceinline__ float wave_max(float v) {
#pragma unroll
    for (int o = 1; o < 64; o <<= 1) v = fmaxf(v, __shfl_xor(v, o));
    return v;
}
__device__ __forceinline__ int modidx(int row) { return row < MP ? (row >> 13) : (8 + ((row - MP) >> 4)); }
__device__ __forceinline__ int crow(int r, int hi) { return (r & 3) + 8 * (r >> 2) + 4 * hi; }
#define LDS_WAIT() asm volatile("s_waitcnt lgkmcnt(0)" ::: "memory")
__device__ __forceinline__ int tid_opaque() { int t = threadIdx.x; asm volatile("" : "+v"(t)); return t; }


#ifdef WT_STORES
__device__ __forceinline__ void st_wt(u32x4* p, u32x4 v) { asm volatile("global_store_dwordx4 %0, %1, off sc0 sc1" :: "v"(p), "v"(v) : "memory"); }
__device__ __forceinline__ void st_wt(f32x4* p, f32x4 v) { asm volatile("global_store_dwordx4 %0, %1, off sc0 sc1" :: "v"(p), "v"(v) : "memory"); }
__device__ __forceinline__ void st_wt(u32x2* p, u32x2 v) { asm volatile("global_store_dwordx2 %0, %1, off sc0 sc1" :: "v"(p), "v"(v) : "memory"); }
__device__ __forceinline__ void st_wt(float* p, float v) { asm volatile("global_store_dword %0, %1, off sc0 sc1" :: "v"(p), "v"(v) : "memory"); }
__device__ __forceinline__ void st_wt(bf16_t* p, bf16_t v) { const unsigned w = v; asm volatile("global_store_short %0, %1, off sc0 sc1" :: "v"(p), "v"(w) : "memory"); }
#else
template <class T> __device__ __forceinline__ void st_wt(T* p, T v) { *p = v; }
#endif
struct EpiUp {
    static constexpr bool PERM = true, AFTER_DRAIN = false;
    KP kp; int roff;
    __device__ __forceinline__ void operator()(const f32x4 (&acc)[2][2][4][2], const pg8::Unit& u, int wr, int wc, int fr, int fq) const {
        const int col = u.pn * 128 + wc * 32 + fq * 8; bf16_t* HID = (bf16_t*)(kp->ws + WS_HID);
#pragma unroll
        for (int ai = 0; ai < 2; ++ai)
#pragma unroll
            for (int m = 0; m < 4; ++m) {
                const int row = roff + u.pm * 256 + ai * 128 + wr * 64 + m * 16 + fr;
                f32x4 h0, h1;
#pragma unroll
                for (int i = 0; i < 4; ++i) { h0[i] = siluf_(acc[ai][0][m][0][i]) * acc[ai][1][m][0][i]; h1[i] = siluf_(acc[ai][0][m][1][i]) * acc[ai][1][m][1][i]; }
                st_wt((u32x4*)(HID + (size_t)row * DFF + col), pack8(h0, h1));
            }
    }
};
struct EpiRes {
    static constexpr bool PERM = true, AFTER_DRAIN = false;
    KP kp; int gi; float scale; int base_in; int roff;
    __device__ __forceinline__ void operator()(const f32x4 (&acc)[2][2][4][2], const pg8::Unit& u, int wr, int wc, int fr, int fq) const {
        const int c0 = u.pn * 256 + wc * 32 + fq * 8;
        const float* xp = kp->in[I_XP]; const float* xs = kp->in[I_XS]; float* X = kp->out + O_Y; const float* mods = (const float*)(kp->ws + WS_MODS);
#pragma unroll
        for (int ai = 0; ai < 2; ++ai)
#pragma unroll
            for (int m = 0; m < 4; ++m) {
                const int row = roff + u.pm * 256 + ai * 128 + wr * 64 + m * 16 + fr;
                if (row < MV) {
                    const float* base = base_in ? (row < MP ? xp + (size_t)row * D : xs + (size_t)(row - MP) * D) : X + (size_t)row * D;
                    const float* gt = mods + (size_t)modidx(row) * NMOD + gi * D;
                    float* xo = X + (size_t)row * D;
#pragma unroll
                    for (int bj = 0; bj < 2; ++bj)
#pragma unroll
                        for (int n = 0; n < 2; ++n) {
                            const int c = c0 + bj * 128 + n * 4;
                            const f32x4 b4 = *(const f32x4*)(base + c), g4 = *(const f32x4*)(gt + c);
                            st_wt((f32x4*)(xo + c), b4 + (g4 * scale) * acc[ai][bj][m][n]);
                        }
                }
            }
    }
};
struct EpiIn {
    static constexpr bool PERM = true, AFTER_DRAIN = false;
    KP kp; int roff;
    __device__ __forceinline__ void operator()(const f32x4 (&acc)[2][2][4][2], const pg8::Unit& u, int wr, int wc, int fr, int fq) const {
        const int pn = u.pn;
        unsigned char* ws = kp->ws; float* out = kp->out;
        bf16_t* Q = (bf16_t*)(ws + WS_Q); bf16_t* KB = (bf16_t*)(ws + WS_KB); bf16_t* VB = (bf16_t*)(ws + WS_VB); bf16_t* U = (bf16_t*)(ws + WS_U); bf16_t* GV = (bf16_t*)(ws + WS_GV); float* SSQ = (float*)(ws + WS_SSQ);
        if (pn < 8) {
            const float* qg = kp->in[I_QG]; const float* kg = kp->in[I_KG];
            const bool isq = pn < 4;
            const float* gvec = isq ? qg : kg; const float osc = isq ? LOG2E * 0.125f : 1.f;
            f32x4 gg[2][2];
#pragma unroll
            for (int bj = 0; bj < 2; ++bj)
#pragma unroll
                for (int n = 0; n < 2; ++n) gg[bj][n] = *(const f32x4*)(gvec + 32 * bj + 8 * fq + 4 * n) * osc;
            const int cb = (pn & 3) * 256 + 64 * wc + 8 * fq;
#pragma unroll
            for (int ai = 0; ai < 2; ++ai)
#pragma unroll
                for (int m = 0; m < 4; ++m) {
                    const int row = roff + u.pm * 256 + ai * 128 + wr * 64 + m * 16 + fr;
                    float ss = 0.f;
#pragma unroll
                    for (int bj = 0; bj < 2; ++bj)
#pragma unroll
                        for (int n = 0; n < 2; ++n) { const f32x4 x = acc[ai][bj][m][n]; ss += (x[0] * x[0] + x[1] * x[1]) + (x[2] * x[2] + x[3] * x[3]); }
                    ss += __shfl_xor(ss, 16); ss += __shfl_xor(ss, 32);
                    const float rstd = rsqrtf(ss * (1.f / 64.f) + EPS);
#pragma unroll
                    for (int bj = 0; bj < 2; ++bj) {
                        const f32x4 o0 = acc[ai][bj][m][0] * rstd * gg[bj][0], o1 = acc[ai][bj][m][1] * rstd * gg[bj][1];
                        const int c = cb + 32 * bj;
                        if (isq) { st_wt((u32x4*)(Q + (size_t)row * D + c), pack8(o0, o1)); }
                        else {
                            st_wt((u32x4*)(KB + (size_t)row * D + c), pack8(o0, o1));
                            if (row < MV) { float* kd = out + (row < MP ? O_KP + (size_t)row * D : O_KS + (size_t)(row - MP) * D) + c; st_wt((f32x4*)kd, o0); st_wt((f32x4*)(kd + 4), o1); }
                        }
                    }
                }
        } else {
            const int sec = (pn - 8) >> 2;
            const int cb = ((pn - 8) & 3) * 256 + 32 * wc + 8 * fq;
#pragma unroll
            for (int ai = 0; ai < 2; ++ai)
#pragma unroll
                for (int m = 0; m < 4; ++m) {
                    const int row = roff + u.pm * 256 + ai * 128 + wr * 64 + m * 16 + fr;
                    float ss = 0.f;
#pragma unroll
                    for (int bj = 0; bj < 2; ++bj) {
                        f32x4 o0 = acc[ai][bj][m][0], o1 = acc[ai][bj][m][1];
                        const int c = cb + 128 * bj;
                        if (sec == 0) {
                            st_wt((u32x4*)(VB + (size_t)row * D + c), pack8(o0, o1));
                            if (row < MV) { float* vd = out + (row < MP ? O_VP + (size_t)row * D : O_VS + (size_t)(row - MP) * D) + c; st_wt((f32x4*)vd, o0); st_wt((f32x4*)(vd + 4), o1); }
                        } else {
                            o0 = gelu4(o0); o1 = gelu4(o1);
                            if (sec == 1) { st_wt((u32x4*)(U + (size_t)row * D + c), pack8(o0, o1)); }
                            else {
                                st_wt((u32x4*)(GV + (size_t)row * D + c), pack8(o0, o1));
                                ss += (o0[0] * o0[0] + o0[1] * o0[1]) + (o0[2] * o0[2] + o0[3] * o0[3]) + (o1[0] * o1[0] + o1[1] * o1[1]) + (o1[2] * o1[2] + o1[3] * o1[3]);
                            }
                        }
                    }
                    if (sec == 2) { ss += __shfl_xor(ss, 16); ss += __shfl_xor(ss, 32); if (fq == 0) st_wt(SSQ + (size_t)((pn - 16) * 4 + wc) * MT + row, ss);     }
                }
        }
    }
};
struct EpiGates {
    static constexpr bool PERM = true, AFTER_DRAIN = false;
    KP kp; int roff;
    __device__ __forceinline__ void operator()(const f32x4 (&acc)[2][2][4][2], const pg8::Unit& u, int wr, int wc, int fr, int fq) const {
        const int c0 = u.pn * 256 + wc * 32 + fq * 8;
        bf16_t* G = (bf16_t*)(kp->ws + WS_GATES); const float* bias = kp->in[I_BGATE];
        f32x4 bv[2][2];
#pragma unroll
        for (int bj = 0; bj < 2; ++bj)
#pragma unroll
            for (int n = 0; n < 2; ++n) bv[bj][n] = *(const f32x4*)(bias + c0 + bj * 128 + n * 4);
#pragma unroll
        for (int ai = 0; ai < 2; ++ai)
#pragma unroll
            for (int m = 0; m < 4; ++m) {
                const int row = roff + u.pm * 256 + ai * 128 + wr * 64 + m * 16 + fr;
#pragma unroll
                for (int bj = 0; bj < 2; ++bj) {
                    f32x4 o0 = acc[ai][bj][m][0] + bv[bj][0], o1 = acc[ai][bj][m][1] + bv[bj][1];
#pragma unroll
                    for (int i = 0; i < 4; ++i) { o0[i] = sigmoidf_(o0[i]); o1[i] = sigmoidf_(o1[i]); }
                    st_wt((u32x4*)(G + (size_t)row * 2048 + c0 + bj * 128), pack8(o0, o1));
                }
            }
    }
};
struct EpiBr {
    static constexpr bool PERM = true, AFTER_DRAIN = false;
    KP kp; int goff; int accum; int roff;
    __device__ __forceinline__ void operator()(const f32x4 (&acc)[2][2][4][2], const pg8::Unit& u, int wr, int wc, int fr, int fq) const {
        const int c0 = u.pn * 256 + wc * 32 + fq * 8;
        const bf16_t* G = (const bf16_t*)(kp->ws + WS_GATES); bf16_t* MX = (bf16_t*)(kp->ws + WS_MIXED);
#pragma unroll
        for (int ai = 0; ai < 2; ++ai)
#pragma unroll
            for (int m = 0; m < 4; ++m) {
                const int row = roff + u.pm * 256 + ai * 128 + wr * 64 + m * 16 + fr;
#pragma unroll
                for (int bj = 0; bj < 2; ++bj) {
                    const int c = c0 + bj * 128;
                    const u32x4 g = *(const u32x4*)(G + (size_t)row * 2048 + goff + c);
                    f32x4 o0 = acc[ai][bj][m][0], o1 = acc[ai][bj][m][1];
                    o0 = o0 * (f32x4){bf_lo(g.x), bf_hi(g.x), bf_lo(g.y), bf_hi(g.y)};
                    o1 = o1 * (f32x4){bf_lo(g.z), bf_hi(g.z), bf_lo(g.w), bf_hi(g.w)};
                    bf16_t* mp = MX + (size_t)row * D + c;
                    if (accum) {
                        const u32x4 pv = *(const u32x4*)mp;
                        o0 = o0 + (f32x4){bf_lo(pv.x), bf_hi(pv.x), bf_lo(pv.y), bf_hi(pv.y)};
                        o1 = o1 + (f32x4){bf_lo(pv.z), bf_hi(pv.z), bf_lo(pv.w), bf_hi(pv.w)};
                    }
                    st_wt((u32x4*)mp, pack8(o0, o1));
                }
            }
    }
};

__device__ __forceinline__ void transpose_item(const float* W, int N, int K, int col0, bf16_t* WT, int prow0, int k0, LAS float* scr, int lane) {
#pragma unroll 8
    for (int i = 0; i < 32; ++i) { const int kk = 2 * i + (lane >> 5); scr[kk * 33 + (lane & 31)] = W[(size_t)(k0 + kk) * N + col0 + (lane & 31)]; }
    LDS_WAIT();
    const int c = lane & 7;
#pragma unroll
    for (int j = 0; j < 4; ++j) {
        const int n = (lane >> 3) + 8 * j; const LAS float* s = scr + (8 * c) * 33 + n;
        u32x4 o; o.x = cvt_pk(s[0 * 33], s[1 * 33]); o.y = cvt_pk(s[2 * 33], s[3 * 33]); o.z = cvt_pk(s[4 * 33], s[5 * 33]); o.w = cvt_pk(s[6 * 33], s[7 * 33]);
        st_wt((u32x4*)(WT + (size_t)(prow0 + n) * K + k0 + 8 * c), o);
    }
    LDS_WAIT();
}
__device__ __forceinline__ void transpose_mat(const float* W, int N, int K, int npos, int kind, bf16_t* WT, int item, LAS float* scr, int lane) {
    const int nblk = npos / 32, kb = item / nblk, pb = item % nblk, p0 = pb * 32;
    int col0 = p0;
    if (kind == 1) { const int pn = p0 >> 8, r = p0 & 255; col0 = (r >> 7) * DFF + 128 * pn + (r & 127); }
    else if (kind == 2 && p0 < 2048) { const int pn = p0 >> 8, r = p0 & 255, bj = r >> 7, wc = (r & 127) >> 5; col0 = 256 * pn + 64 * wc + 32 * bj; }
    transpose_item(W, N, K, col0, WT, p0, kb * 64, scr, lane);
}

__device__ __forceinline__ void prologue(KP p, LAS unsigned char* lds, int vcu, int G) {
    const int tid = tid_opaque(), lane = tid & 63, wid = __builtin_amdgcn_readfirstlane(tid >> 6);
    unsigned char* ws = p->ws;
    float* mods = (float*)(ws + WS_MODS);
    if (vcu < NMOD / 64) {
        LAS float* sc = (LAS float*)lds;
        LAS float* red = (LAS float*)(lds + 65536);
        for (int i = tid; i < 16 * D; i += 512) { const int r = i >> 10, k = i & 1023; const float c = r < 8 ? p->in[I_CP][r * D + k] : p->in[I_CS][(r - 8) * D + k]; sc[i] = siluf_(c); }
        __syncthreads();
        const int n0 = vcu * 64;
        float acc[16];
#pragma unroll
        for (int r = 0; r < 16; ++r) acc[r] = 0.f;
        const float* w = p->in[I_ADAW] + (size_t)(128 * wid) * NMOD + n0 + lane;
        for (int k4 = 0; k4 < 32; ++k4) {
            float wv[4];
#pragma unroll
            for (int i = 0; i < 4; ++i) wv[i] = w[(size_t)(k4 * 4 + i) * NMOD];
#pragma unroll
            for (int r = 0; r < 16; ++r) { const f32x4 s4 = *(const LAS f32x4*)(sc + r * D + 128 * wid + 4 * k4); acc[r] += (s4[0] * wv[0] + s4[1] * wv[1]) + (s4[2] * wv[2] + s4[3] * wv[3]); }
        }
#pragma unroll
        for (int r = 0; r < 16; ++r) red[(wid * 16 + r) * 64 + lane] = acc[r];
        __syncthreads();
        for (int o = tid; o < 1024; o += 512) {
            const int r = o >> 6, c = o & 63; float s = 0.f;
#pragma unroll
            for (int w8 = 0; w8 < 8; ++w8) s += red[(w8 * 16 + r) * 64 + c];
            st_wt(mods + (size_t)r * NMOD + n0 + c, s + p->in[I_ADAB][n0 + c]);
        }
        __syncthreads();
    }
    {
        const int e = vcu * 512 + tid;
        if (e < 8 * 4 * 8 * 64) {
            const int ln = e & 63, ks = (e >> 6) & 7, mt = (e >> 9) & 3, gg = e >> 11, r32_ = ln & 31, hi_ = ln >> 5;
            const int t = 32 * mt + r32_, s0 = 16 * ks + 4 * hi_;
            const float* wp = p->in[I_GWS] + (size_t)gg * 16384 + t * 128 + s0;
            f32x4 a0 = *(const f32x4*)wp, a1 = *(const f32x4*)(wp + 8);
#pragma unroll
            for (int i = 0; i < 4; ++i) { if (s0 + i > t) a0[i] = 0.f; if (s0 + 8 + i > t) a1[i] = 0.f; }
            st_wt((u32x4*)(ws + WS_WF) + e, pack8(a0, a1));
        }
    }
    LAS float* scr = (LAS float*)(lds + wid * 16384);
    const int gw = vcu * 8 + wid, NGW = G * 8;
    constexpr int I_UP = 16 * 176, I_DN = 44 * 32, I_IN = 16 * 160, I_GT = 16 * 64, I_SQ = 16 * 32;
    constexpr int NITEMS = 2 * I_UP + 2 * I_DN + I_IN + I_GT + 3 * I_SQ;
    for (int it = gw; it < NITEMS; it += NGW) {
        int r = it;
        if (r < I_UP) { transpose_mat(p->in[I_WGU1], 2 * DFF, D, 2 * DFF, 1, (bf16_t*)(ws + WS_WGU1), r, scr, lane); continue; } r -= I_UP;
        if (r < I_UP) { transpose_mat(p->in[I_WGU2], 2 * DFF, D, 2 * DFF, 1, (bf16_t*)(ws + WS_WGU2), r, scr, lane); continue; } r -= I_UP;
        if (r < I_DN) { transpose_mat(p->in[I_WD1], D, DFF, D, 0, (bf16_t*)(ws + WS_WD1), r, scr, lane); continue; } r -= I_DN;
        if (r < I_DN) { transpose_mat(p->in[I_WD2], D, DFF, D, 0, (bf16_t*)(ws + WS_WD2), r, scr, lane); continue; } r -= I_DN;
        if (r < I_IN) { transpose_mat(p->in[I_WIN], 5120, D, 5120, 2, (bf16_t*)(ws + WS_WIN), r, scr, lane); continue; } r -= I_IN;
        if (r < I_GT) { transpose_mat(p->in[I_WGATE], 2048, D, 2048, 0, (bf16_t*)(ws + WS_WGT), r, scr, lane); continue; } r -= I_GT;
        if (r < I_SQ) { transpose_mat(p->in[I_WBR], D, D, D, 0, (bf16_t*)(ws + WS_WBA), r, scr, lane); continue; } r -= I_SQ;
        if (r < I_SQ) { transpose_mat(p->in[I_WBR] + (size_t)D * D, D, D, D, 0, (bf16_t*)(ws + WS_WBB), r, scr, lane); continue; } r -= I_SQ;
        transpose_mat(p->in[I_WOUT], D, D, D, 0, (bf16_t*)(ws + WS_WOUT), r, scr, lane);
    }
}

__device__ __forceinline__ void norm_rows(KP p, int mode, int vcu, int G) {
    const int tid = tid_opaque(), lane = tid & 63, wid = tid >> 6;
    const int gw = vcu * 8 + wid, NGW = G * 8;
    float* X = p->out + O_Y; bf16_t* HN = (bf16_t*)(p->ws + (mode == 1 ? WS_HN2 : WS_HN)); const float* mods = (const float*)(p->ws + WS_MODS);
    const float* g = p->in[I_NORMG] + mode * D;
    f32x4 g4[4];
#pragma unroll
    for (int j = 0; j < 4; ++j) g4[j] = ((const f32x4*)g)[64 * j + lane];
    for (int row = gw; row < MV; row += NGW) {
        const float* src = mode == 0 ? (row < MP ? p->in[I_XP] + (size_t)row * D : p->in[I_XS] + (size_t)(row - MP) * D) : X + (size_t)row * D;
        f32x4 v[4]; float s = 0.f;
#pragma unroll
        for (int j = 0; j < 4; ++j) { v[j] = ((const f32x4*)src)[64 * j + lane]; s += (v[j][0] * v[j][0] + v[j][1] * v[j][1]) + (v[j][2] * v[j][2] + v[j][3] * v[j][3]); }
        const float rstd = rsqrtf(wave_sum(s) * (1.f / D) + EPS);
        if (mode < 3) {
            const float* sh = mods + (size_t)modidx(row) * NMOD + (3 * mode) * D; const float* sc = sh + D;
            u32x2* o8 = (u32x2*)(HN + (size_t)row * D);
#pragma unroll
            for (int j = 0; j < 4; ++j) {
                const f32x4 s4 = ((const f32x4*)sc)[64 * j + lane], h4 = ((const f32x4*)sh)[64 * j + lane];
                const f32x4 o = (v[j] * rstd) * g4[j] * (s4 + 1.f) + h4;
                u32x2 w; w.x = cvt_pk(o[0], o[1]); w.y = cvt_pk(o[2], o[3]); st_wt(o8 + 64 * j + lane, w);
            }
        } else {
#ifdef PROBE_YS
            const float pfac = row < MP ? PROBE_YS : 1.f;
#else
            const float pfac = 1.f;
#endif
#pragma unroll
            for (int j = 0; j < 4; ++j) ((f32x4*)(X + (size_t)row * D))[64 * j + lane] = (v[j] * (rstd * pfac)) * g4[j];
        }
    }
}

#ifndef PROBE_EXPLICIT_BIAS
#define PROBE_EXPLICIT_BIAS 0
#endif
__device__ __forceinline__ void glds16(const void* gsrc, unsigned lds_dst) {
    unsigned keep; const unsigned dst = (unsigned)__builtin_amdgcn_readfirstlane((int)lds_dst);
    asm volatile("s_mov_b32 %0, m0\n\ts_mov_b32 m0, %2\n\ts_nop 0\n\tglobal_load_lds_dwordx4 %1, off\n\ts_mov_b32 m0, %0" : "=&s"(keep) : "v"(gsrc), "s"(dst) : "memory");
}
__device__ __forceinline__ v4i16_t vtr(const LAS unsigned char* p) { return __builtin_amdgcn_ds_read_tr16_b64_v4i16((LAS v4i16_t*)p); }
__device__ __forceinline__ void attn_unit(const bf16_t* Q, const bf16_t* Kb, const bf16_t* Vb, bf16_t* O, const float* subg,
                                          int b, int h, int j, LAS unsigned char* lds, float lam, float M2, float win) {
    const int tid = tid_opaque(), lane = tid & 63, r32 = lane & 31, hi = lane >> 5;
    const int wid = __builtin_amdgcn_readfirstlane(tid >> 6);
    const int m = wid & 1, rg = wid >> 1;
    const int q0 = 128 * j + 32 * rg, myc = 2 * j + (rg >> 1), ntiles = 2 * j + 2;
    int kt0 = (int)floorf((128.f * (float)j - 63.f - win) * (1.f / 64.f)) + 1; kt0 = kt0 < 0 ? 0 : kt0;
    const size_t rowbase = (size_t)b * TSEQ;
    const float slope2 = ldexpf(LOG2E, -(h + 1));
    const bf16_t* ksrc = Kb + (rowbase + (tid & 63)) * D + h * 128 + (tid >> 6) * 8;
    const bf16_t* vsrc = Vb + (rowbase + 16 * (wid & 3) + (lane >> 2)) * D + h * 128 + 32 * (wid >> 2) + 8 * (lane & 3);
    bf16x8 qr[4];
    { const bf16_t* qw = Q + (rowbase + q0 + r32) * D + h * 128 + m * 64 + 8 * hi;
#pragma unroll
      for (int d0 = 0; d0 < 4; ++d0) qr[d0] = *(const bf16x8*)(qw + 16 * d0); }
    asm volatile("" : "+v"(qr[0]), "+v"(qr[1]), "+v"(qr[2]), "+v"(qr[3]));
    const float pa = -slope2 * (float)(r32 - 4 * hi);
    f32x16 o[4];
#pragma unroll
    for (int d0 = 0; d0 < 4; ++d0)
#pragma unroll
        for (int r = 0; r < 16; ++r) o[d0][r] = 0.f;
    float lsum = 0.f;
    const int koff = (m * 8 + hi) * 1024 + r32 * 16;
    const int voff = 16384 + ((lane >> 4) & 1) * 32 + (lane & 3) * 8 + (4 * hi + ((lane & 15) >> 2)) * 64;
    const unsigned lbase = (unsigned)(uintptr_t)lds + (unsigned)wid * 1024u;
#define ATT_STAGE(kt_, s_) do { const size_t go_ = (size_t)(kt_) * 64 * D; const unsigned lb_ = lbase + (unsigned)(s_) * 32768u; \
        glds16(ksrc + go_, lb_); glds16(ksrc + go_ + 64, lb_ + 8192u); glds16(vsrc + go_, lb_ + 16384u); glds16(vsrc + go_ + 64, lb_ + 24576u); } while (0)
    ATT_STAGE(kt0, kt0 & 3); ATT_STAGE(kt0 + 1, (kt0 + 1) & 3);
    if (kt0 + 2 < ntiles) { ATT_STAGE(kt0 + 2, (kt0 + 2) & 3); asm volatile("s_waitcnt vmcnt(8)" ::: "memory"); }
    else asm volatile("s_waitcnt vmcnt(4)" ::: "memory");
    __syncthreads();
    for (int kt = kt0; kt < ntiles; ++kt) {
        const LAS unsigned char* buf = lds + (kt & 3) * 32768;
        const bool more = kt + 3 < ntiles;
        if (more) ATT_STAGE(kt + 3, (kt + 3) & 3);
        if (kt <= myc) {
            f32x16 p0, p1;
            if (kt < myc && !PROBE_EXPLICIT_BIAS) {
                const float c0 = pa - slope2 * (float)(q0 - 64 * kt) - M2, c1 = c0 + 32.f * slope2;
#pragma unroll
                for (int r = 0; r < 16; ++r) { const float kr = (float)((r & 3) + 8 * (r >> 2)); p0[r] = fmaf(slope2, kr, c0); p1[r] = fmaf(slope2, kr, c1); }
            } else {
#pragma unroll
                for (int r = 0; r < 16; ++r) { const float dq = (float)(q0 + r32 - 64 * kt - crow(r, hi)); p0[r] = -slope2 * fabsf(dq) - M2; p1[r] = -slope2 * fabsf(dq - 32.f) - M2; }
            }
            const LAS unsigned char* kb = buf + koff;
            bf16x8 kf[8];
#pragma unroll
            for (int d0 = 0; d0 < 4; ++d0) { kf[2 * d0] = *(const LAS bf16x8*)(kb + d0 * 2048); kf[2 * d0 + 1] = *(const LAS bf16x8*)(kb + d0 * 2048 + 512); }
            __builtin_amdgcn_sched_barrier(0);
#pragma unroll
            for (int d0 = 0; d0 < 4; ++d0) {
                p0 = __builtin_amdgcn_mfma_f32_32x32x16_bf16(kf[2 * d0], qr[d0], p0, 0, 0, 0);
                p1 = __builtin_amdgcn_mfma_f32_32x32x16_bf16(kf[2 * d0 + 1], qr[d0], p1, 0, 0, 0);
            }
            float sa = 0.f, sb = 0.f;
#pragma unroll
            for (int r = 0; r < 16; ++r) { p0[r] = __builtin_amdgcn_exp2f(p0[r]); p1[r] = __builtin_amdgcn_exp2f(p1[r]); sa += p0[r]; sb += p1[r]; }
            lsum += sa + sb;
            u32x4 pw[4];
            pw[0] = (u32x4){cvt_pk(p0[0], p0[1]), cvt_pk(p0[2], p0[3]), cvt_pk(p0[4], p0[5]), cvt_pk(p0[6], p0[7])};
            pw[1] = (u32x4){cvt_pk(p0[8], p0[9]), cvt_pk(p0[10], p0[11]), cvt_pk(p0[12], p0[13]), cvt_pk(p0[14], p0[15])};
            pw[2] = (u32x4){cvt_pk(p1[0], p1[1]), cvt_pk(p1[2], p1[3]), cvt_pk(p1[4], p1[5]), cvt_pk(p1[6], p1[7])};
            pw[3] = (u32x4){cvt_pk(p1[8], p1[9]), cvt_pk(p1[10], p1[11]), cvt_pk(p1[12], p1[13]), cvt_pk(p1[14], p1[15])};
            const LAS unsigned char* vb = buf + voff;
#pragma unroll
            for (int d0 = 0; d0 < 4; ++d0) {
                v4i16_t lo[4], hh[4];
#pragma unroll
                for (int ks = 0; ks < 4; ++ks) { lo[ks] = vtr(vb + d0 * 4096 + ks * 1024); hh[ks] = vtr(vb + d0 * 4096 + ks * 1024 + 512); }
#pragma unroll
                for (int ks = 0; ks < 4; ++ks) {
                    const bf16x8 vf = (bf16x8){lo[ks][0], lo[ks][1], lo[ks][2], lo[ks][3], hh[ks][0], hh[ks][1], hh[ks][2], hh[ks][3]};
                    o[d0] = __builtin_amdgcn_mfma_f32_32x32x16_bf16(__builtin_bit_cast(bf16x8, pw[ks]), vf, o[d0], 0, 0, 0);
                }
            }
        }
        if (more) asm volatile("s_waitcnt vmcnt(8)" ::: "memory");
        else asm volatile("s_waitcnt vmcnt(0)" ::: "memory");
        __syncthreads();
    }
    lsum += __shfl_xor(lsum, 32);
    LAS float* wsf = (LAS float*)(lds + 131072) + wid * 32;
    if (hi == 0) wsf[r32] = lsum;
    LDS_WAIT();
    float f[16];
    const float fs = m == 0 ? 1.f : -lam;
#pragma unroll
    for (int r = 0; r < 16; ++r) f[r] = fs / wsf[crow(r, hi)];
    LAS float* CB = (LAS float*)lds;
    if (m == 1) {
#pragma unroll
        for (int d0 = 0; d0 < 4; ++d0)
#pragma unroll
            for (int r = 0; r < 16; ++r) CB[(32 * rg + crow(r, hi)) * 132 + 32 * d0 + r32] = o[d0][r] * f[r];
    }
    __syncthreads();
    if (m == 0) {
#pragma unroll
        for (int d0 = 0; d0 < 4; ++d0)
#pragma unroll
            for (int r = 0; r < 16; ++r) CB[(32 * rg + crow(r, hi)) * 132 + 32 * d0 + r32] += o[d0][r] * f[r];
    }
    __syncthreads();
    {
        const int row = tid >> 2, part = tid & 3;
        f32x4 v[8]; float ss = 0.f;
#pragma unroll
        for (int i = 0; i < 8; ++i) { v[i] = *(const LAS f32x4*)(CB + row * 132 + 32 * part + 4 * i); ss += (v[i][0] * v[i][0] + v[i][1] * v[i][1]) + (v[i][2] * v[i][2] + v[i][3] * v[i][3]); }
        ss += __shfl_xor(ss, 1); ss += __shfl_xor(ss, 2);
        const float rstd = rsqrtf(ss * (1.f / 128.f) + EPS) * 0.8f;
        bf16_t* op = O + (rowbase + 128 * j + row) * D + h * 128 + 32 * part;
#pragma unroll
        for (int i = 0; i < 4; ++i) {
            const f32x4 ga = *(const f32x4*)(subg + 32 * part + 8 * i), gb = *(const f32x4*)(subg + 32 * part + 8 * i + 4);
            st_wt((u32x4*)(op + 8 * i), pack8(v[2 * i] * rstd * ga, v[2 * i + 1] * rstd * gb));
        }
    }
    __syncthreads();
#undef ATT_STAGE
}

__device__ __forceinline__ void spatial_unit(const bf16_t* GV, bf16_t* US, const float* SSQ, const float* vg, const float* Ws, const float* bs, int ci, LAS unsigned char* lds, const unsigned char* WFp, unsigned char* DBGP = nullptr, bf16_t* USo = nullptr) {
    const int tid = tid_opaque(), lane = tid & 63, r32 = lane & 31, hi = lane >> 5;
    const int g = __builtin_amdgcn_readfirstlane(tid >> 6);
    LAS unsigned char* wbuf = lds + g * 16384;
    LAS float* rst = (LAS float*)(lds + 131072) + g * 128;
    const int R0 = 128 * ci;
#pragma unroll
    for (int i = 0; i < 2; ++i) {
        const int rr = lane + 64 * i; float s = 0.f;
#pragma unroll
        for (int sl = 0; sl < 16; ++sl) s += SSQ[(size_t)sl * MT + R0 + rr];
        rst[rr] = rsqrtf(s * (1.f / 1024.f) + EPS);
    }
    LDS_WAIT();
    const int laneoff = ((lane >> 4) & 1) * 32 + (lane & 3) * 8 + (4 * hi + ((lane & 15) >> 2)) * 64;
    const float* Wg = Ws + (size_t)g * 16384; (void)Wg;
    const u32x4* Wf = (const u32x4*)WFp;
    for (int hh = 0; hh < 2; ++hh) {
#pragma unroll 4
        for (int pc = 0; pc < 16; ++pc) {
            const int d0 = pc >> 3, ks = pc & 7, row = 16 * ks + (lane >> 2), col = g * 128 + 64 * hh + 32 * d0 + 8 * (lane & 3);
            const u32x4 raw = *(const u32x4*)(GV + (size_t)(R0 + row) * D + col);
            const float rs = rst[row];
            const f32x4 ga = *(const f32x4*)(vg + col) * rs, gb = *(const f32x4*)(vg + col + 4) * rs;
            const f32x4 a = (f32x4){bf_lo(raw.x), bf_hi(raw.x), bf_lo(raw.y), bf_hi(raw.y)} * ga, b4 = (f32x4){bf_lo(raw.z), bf_hi(raw.z), bf_lo(raw.w), bf_hi(raw.w)} * gb;
            *(LAS u32x4*)(wbuf + pc * 1024 + lane * 16) = pack8(a, b4);
        }
        LDS_WAIT();
#pragma unroll 1
        for (int mt = 0; mt < 4; ++mt) {
            f32x16 o[2];
#pragma unroll
            for (int nt = 0; nt < 2; ++nt)
#pragma unroll
                for (int r = 0; r < 16; ++r) o[nt][r] = 0.f;
#pragma unroll 2
            for (int ks = 0; ks < 2 * mt + 2; ++ks) {
                bf16x8 vf[2];
#pragma unroll
                for (int nt = 0; nt < 2; ++nt) {
                    const v4i16_t lo = vtr(wbuf + nt * 8192 + ks * 1024 + laneoff), hh2 = vtr(wbuf + nt * 8192 + ks * 1024 + 512 + laneoff);
                    vf[nt] = (bf16x8){lo[0], lo[1], lo[2], lo[3], hh2[0], hh2[1], hh2[2], hh2[3]};
                }
                const bf16x8 af = __builtin_bit_cast(bf16x8, Wf[((g * 4 + mt) * 8 + ks) * 64 + lane]);
#pragma unroll
                for (int nt = 0; nt < 2; ++nt) o[nt] = __builtin_amdgcn_mfma_f32_32x32x16_bf16(af, vf[nt], o[nt], 0, 0, 0);
            }
#ifdef SELFCHK2
            {
                const int tt = 32 * mt + crow(5, hi), col = g * 128 + 64 * hh + 32 + r32;
                float mixn = bs[g * 128 + tt];
                for (int s = 0; s <= tt; ++s) mixn += Wg[tt * 128 + s] * (bf2f(GV[(size_t)(R0 + s) * D + col]) * rst[s] * vg[col]);
                const float mf = o[1][5] + bs[g * 128 + tt];
                const float rel = fabsf(mf - mixn) / (fabsf(mixn) + 0.1f);
                if (rel > 0.05f) atomicAdd((unsigned*)DBGP + 1, 1u);
                atomicAdd((unsigned*)DBGP + 2, 1u);
            }
#endif
#pragma unroll
            for (int r = 0; r < 16; ++r) {
                const int tt = 32 * mt + crow(r, hi); const float bb = bs[g * 128 + tt];
#pragma unroll
                for (int nt = 0; nt < 2; ++nt) {
                    bf16_t* up = US + (size_t)(R0 + tt) * D + g * 128 + 64 * hh + 32 * nt + r32;
                    bf16_t* uo = (USo ? USo : US) + (size_t)(R0 + tt) * D + g * 128 + 64 * hh + 32 * nt + r32;
#ifdef PROBE_NOWV
                    st_wt(uo, f2bf(bf2f(*up) * (0.f * o[nt][r] + bb)));
#else
                    st_wt(uo, f2bf(bf2f(*up) * (o[nt][r] + bb)));
#endif
                }
            }
        }
        LDS_WAIT();
    }
}

__device__ __forceinline__ void sample_spatial_unit(const bf16_t* GV, bf16_t* US, const float* SSQ, const float* vg, const float* Ws, const float* bs, float* gs_out, int b, LAS unsigned char* lds) {
    const int tid = tid_opaque();
    LAS float* rst = (LAS float*)lds;
    if (tid < 16) { float s = 0.f; for (int i = 0; i < 16; ++i) s += SSQ[(size_t)i * MT + MP + 16 * b + tid]; rst[tid] = rsqrtf(s * (1.f / 1024.f) + EPS); }
    __syncthreads();
    for (int c = tid; c < D; c += 512) {
        const int g = c >> 7; const float gc = vg[c];
        float gvn[16];
#pragma unroll
        for (int s = 0; s < 16; ++s) { gvn[s] = bf2f(GV[(size_t)(MP + 16 * b + s) * D + c]) * rst[s] * gc; gs_out[(size_t)(16 * b + s) * D + c] = gvn[s]; }
#pragma unroll
        for (int t = 0; t < 16; ++t) {
            float mix = bs[g * 128 + t];
#pragma unroll
            for (int s = 0; s < 16; ++s) if (s <= t) mix += Ws[(size_t)g * 16384 + t * 128 + s] * gvn[s];
            bf16_t* up = US + (size_t)(MP + 16 * b + t) * D + c;
            st_wt(up, f2bf(bf2f(*up) * mix));
        }
    }
    __syncthreads();
}

__device__ __forceinline__ void sample_attn_unit(KP p, const bf16_t* Q, bf16_t* O, int b, int h, int qg4, float lam, LAS unsigned char* lds) {
    const int tid = tid_opaque(), lane = tid & 63, wid = tid >> 6;
    constexpr int NK = 1040;
    LAS float* qs = (LAS float*)lds;
    LAS float* scb = (LAS float*)(lds + 8192);
    LAS float* lrow = (LAS float*)(lds + 8192 + 4 * NK * 4);
    LAS float* red = lrow + 4;
    LAS float* part = (LAS float*)(lds + 32768);
    const float* KS = p->out + O_KS; const float* VS = p->out + O_VS;
    const float slope2 = ldexpf(LOG2E, -(h + 1));
    const int qrow0 = 16 * b + 4 * qg4;
    { const int mm = tid >> 8, q = (tid >> 6) & 3, dd = tid & 63; qs[tid] = bf2f(Q[(size_t)(MP + qrow0 + q) * D + h * 128 + mm * 64 + dd]); }
    __syncthreads();
    const int qi = tid >> 7, d = tid & 127;
    float res = 0.f;
    for (int m = 0; m < 2; ++m) {
        for (int kk = tid; kk < NK; kk += 512) {
            const float* kp = kk < 1024 ? p->in[I_CK] + (((size_t)b * 1024 + kk) * 8 + h) * 128 + m * 64 : KS + (size_t)(16 * b + kk - 1024) * D + h * 128 + m * 64;
            f32x4 kv[16];
#pragma unroll
            for (int i = 0; i < 16; ++i) kv[i] = ((const f32x4*)kp)[i];
#pragma unroll
            for (int q = 0; q < 4; ++q) {
                const LAS f32x4* qp = (const LAS f32x4*)(qs + (m * 4 + q) * 64);
                float dot = 0.f;
#pragma unroll
                for (int i = 0; i < 16; ++i) { const f32x4 q4 = qp[i]; dot += (q4[0] * kv[i][0] + q4[1] * kv[i][1]) + (q4[2] * kv[i][2] + q4[3] * kv[i][3]); }
                scb[q * NK + kk] = dot - slope2 * fabsf((float)(1024 + 4 * qg4 + q - kk));
            }
        }
        __syncthreads();
        if (wid < 4) {
            float mx = -3.0e38f;
            for (int kk = lane; kk < NK; kk += 64) mx = fmaxf(mx, scb[wid * NK + kk]);
            mx = wave_max(mx);
            float sum = 0.f;
            for (int kk = lane; kk < NK; kk += 64) { const float e = __builtin_amdgcn_exp2f(scb[wid * NK + kk] - mx); scb[wid * NK + kk] = e; sum += e; }
            sum = wave_sum(sum);
            if (lane == 0) lrow[wid] = sum;
        }
        __syncthreads();
        {
            const int ksl = tid >> 7, k0 = ksl * 260, k1 = k0 + 260;
            float a4[4] = {0.f, 0.f, 0.f, 0.f};
            const float* cv = p->in[I_CV] + ((size_t)b * 1024 * 8 + h) * 128 + d;
#pragma unroll 8
            for (int kk = k0; kk < k1; ++kk) {
                const float v = kk < 1024 ? cv[(size_t)kk * 1024] : VS[(size_t)(16 * b + kk - 1024) * D + h * 128 + d];
#pragma unroll
                for (int q = 0; q < 4; ++q) a4[q] += scb[q * NK + kk] * v;
            }
#pragma unroll
            for (int q = 0; q < 4; ++q) part[(ksl * 4 + q) * 128 + d] = a4[q];
            __syncthreads();
            const float acc = (part[(0 * 4 + qi) * 128 + d] + part[(1 * 4 + qi) * 128 + d]) + (part[(2 * 4 + qi) * 128 + d] + part[(3 * 4 + qi) * 128 + d]);
            res += (m == 0 ? 1.f : -lam) * acc / lrow[qi];
        }
        __syncthreads();
    }
    { const float s = wave_sum(res * res); if (lane == 0) red[wid] = s; }
    __syncthreads();
    const float tot = red[2 * qi] + red[2 * qi + 1];
    const float rstd = rsqrtf(tot * (1.f / 128.f) + EPS);
    st_wt(O + (size_t)(MP + qrow0 + qi) * D + h * 128 + d, f2bf(res * rstd * p->in[I_SUBG][d] * 0.8f));
    __syncthreads();
}

#if defined(SELFCHK) || defined(O_SEPARATE)
constexpr size_t WS_O2 = 840 * MiB;
#endif
#ifdef SELFCHK
constexpr size_t WS_DBG = WS_END + 32768;
__device__ __forceinline__ void check_attn_rows(KP p, int b, int h, int t0, float lam, LAS unsigned char* lds) {
    const int tid = tid_opaque(), lane = tid & 63, wid = tid >> 6;
    const bf16_t* Q = (const bf16_t*)(p->ws + WS_Q); const bf16_t* KB = (const bf16_t*)(p->ws + WS_KB); const bf16_t* VB = (const bf16_t*)(p->ws + WS_VB);
    const bf16_t* O2 = (const bf16_t*)(p->ws + WS_O2);
    LAS float* scb = (LAS float*)lds;
    LAS float* qs = (LAS float*)(lds + 131072);
    LAS float* lrow = qs + 512;
    LAS float* red = lrow + 4;
    const size_t rowbase = (size_t)b * TSEQ;
    const int kend = 64 * (t0 / 64 + 1);
    const float slope2 = ldexpf(LOG2E, -(h + 1));
    { const int mm = tid >> 8, qi = (tid >> 6) & 3, d = tid & 63; qs[tid] = bf2f(Q[(rowbase + t0 + qi) * D + h * 128 + mm * 64 + d]); }
    __syncthreads();
    const int qi = tid >> 7, d = tid & 127;
    float res = 0.f;
    for (int mm = 0; mm < 2; ++mm) {
        for (int kk = tid; kk < kend; kk += 512) {
            const bf16_t* kp = KB + (rowbase + kk) * D + h * 128 + mm * 64;
            float dot[4] = {0.f, 0.f, 0.f, 0.f};
            for (int dd = 0; dd < 64; ++dd) { const float kv = bf2f(kp[dd]);
#pragma unroll
                for (int q = 0; q < 4; ++q) dot[q] += qs[(mm * 4 + q) * 64 + dd] * kv; }
#pragma unroll
            for (int q = 0; q < 4; ++q) scb[q * 8192 + kk] = dot[q] - slope2 * fabsf((float)(t0 + q - kk));
        }
        __syncthreads();
        if (wid < 4) {
            float mx = -3.0e38f;
            for (int kk = lane; kk < kend; kk += 64) mx = fmaxf(mx, scb[wid * 8192 + kk]);
            mx = wave_max(mx);
            float sum = 0.f;
            for (int kk = lane; kk < kend; kk += 64) { const float e = __builtin_amdgcn_exp2f(scb[wid * 8192 + kk] - mx); scb[wid * 8192 + kk] = e; sum += e; }
            sum = wave_sum(sum);
            if (lane == 0) lrow[wid] = sum;
        }
        __syncthreads();
        float acc = 0.f;
        for (int kk = 0; kk < kend; ++kk) acc += scb[qi * 8192 + kk] * bf2f(VB[(rowbase + kk) * D + h * 128 + d]);
        res += (mm == 0 ? 1.f : -lam) * acc / lrow[qi];
        __syncthreads();
    }
    { const float s = wave_sum(res * res); if (lane == 0) red[wid * 2] = s; }
    __syncthreads();
    const float tot = red[(2 * qi) * 2] + red[(2 * qi + 1) * 2];
    const float ref = res * rsqrtf(tot * (1.f / 128.f) + EPS) * p->in[I_SUBG][d] * 0.8f;
    const float fast = bf2f(O2[(rowbase + t0 + qi) * D + h * 128 + d]);
    __syncthreads();
    { const float e2 = wave_sum((fast - ref) * (fast - ref)), r2 = wave_sum(ref * ref); if (lane == 0) { red[wid * 2] = e2; red[wid * 2 + 1] = r2; } }
    __syncthreads();
    if (tid < 4) {
        const float e2 = red[(2 * tid) * 2] + red[(2 * tid + 1) * 2], r2 = red[(2 * tid) * 2 + 1] + red[(2 * tid + 1) * 2 + 1];
        const float rel = sqrtf(e2 / (r2 + 1e-30f));
        atomicMax((unsigned*)(p->ws + WS_DBG), __float_as_uint(rel));
        if (rel > 0.1f) atomicAdd((unsigned*)(p->ws + WS_DBG) + 1, 1u);
        atomicAdd((unsigned*)(p->ws + WS_DBG) + 2, 1u);
    }
    __syncthreads();
}
#endif

#ifdef SELFCHK4
__device__ __forceinline__ float chk_dot(const bf16_t* arow, const float* W, int ldw, int col, int K, int ln) {
    float s = 0.f;
    for (int k = ln; k < K; k += 64) s += bf2f(arow[k]) * W[(size_t)k * ldw + col];
    return wave_sum(s);
}
__device__ __forceinline__ void check_gemms(KP p, int which, int vcu, int G) {
    const int tid = tid_opaque(), ln = tid & 63, wv = tid >> 6;
    unsigned char* ws = p->ws; unsigned* dbg = (unsigned*)(ws + WS_END + 32768);
    const bf16_t* HNp = (const bf16_t*)(ws + (which == 0 ? WS_HN2 : WS_HN)); const bf16_t* GT = (const bf16_t*)(ws + WS_GATES);
    const bf16_t* OB = (const bf16_t*)(ws + WS_Q); const bf16_t* SB = (const bf16_t*)(ws + WS_U); const bf16_t* MX = (const bf16_t*)(ws + WS_MIXED);
    unsigned nb = 0, nt = 0;
    for (int it = 0; it < 32; ++it) {
#ifdef CHK4_ROWWISE
        const unsigned id = (unsigned)(vcu * 8 + wv);
        const unsigned hsh = id * 2654435761u;
        const int row = (int)(hsh >> 8) % CHK4_ROWS + CHK4_ROW0; const int col = (it * 32 + (int)(hsh & 31)) & 1023;
#else
        const unsigned id = (unsigned)((vcu * 8 + wv) * 32 + it);
        const unsigned hsh = id * 2654435761u;
        const int row = (int)(hsh >> 8) % CHK4_ROWS + CHK4_ROW0; const int col = (int)((hsh * 40503u) >> 12) & 1023;
#endif
        if (which == 0) {
#pragma unroll 1
            for (int hf = 0; hf < 2; ++hf) {
                const int c = col + 1024 * hf;
                const float z = chk_dot(HNp + (size_t)row * D, p->in[I_WGATE], 2048, c, D, ln) + p->in[I_BGATE][c];
                const size_t gi_ = (size_t)row * 2048 + c;
                const float ref = 1.f / (1.f + expf(-z)), got = bf2f(GT[gi_]);
                const unsigned wcoh = __hip_atomic_load((const unsigned*)(GT + (gi_ & ~(size_t)1)), __ATOMIC_RELAXED, __HIP_MEMORY_SCOPE_AGENT);
                const float gotc = (gi_ & 1) ? bf_hi(wcoh) : bf_lo(wcoh);
#if defined(CHK4_MODE) && CHK4_MODE == 1
                if (got != gotc) ++nb;
#elif defined(CHK4_MODE) && CHK4_MODE == 5
                if (fabsf(ref - gotc) > 0.02f && row < 32768) {
                    const float kold = bf2f(f2bf(p->out[O_KP + (size_t)(2 * row + hf) * D + col]));
                    if (gotc == kold) ++nb;
                }
#elif defined(CHK4_MODE) && CHK4_MODE == 4
                if (fabsf(ref - gotc) > 0.02f && fabsf(gotc) < 1e-6f) ++nb;
#elif defined(CHK4_MODE) && CHK4_MODE == 3
                if (fabsf(ref - gotc) > 0.02f && (gotc < 0.f || gotc > 1.f)) ++nb;
#elif defined(CHK4_MODE) && CHK4_MODE == 2
                if (fabsf(ref - gotc) > 0.02f) ++nb;
#else
                if (fabsf(ref - got) > 0.02f) ++nb;
#endif
                ++nt;
            }
        } else if (which == 2) {
            const bf16_t* HIDp = (const bf16_t*)(ws + WS_HID);
#pragma unroll 1
            for (int hf = 0; hf < 2; ++hf) {
                const int j = col + 1024 * hf;
                const float gg = chk_dot(HNp + (size_t)row * D, p->in[I_WGU1], 2 * DFF, j, D, ln), uu = chk_dot(HNp + (size_t)row * D, p->in[I_WGU1], 2 * DFF, DFF + j, D, ln);
                const float ref = gg / (1.f + expf(-gg)) * uu, got = bf2f(HIDp[(size_t)row * DFF + j]);
                if (fabsf(ref - got) > 0.03f * (fabsf(ref) + 0.3f)) ++nb;
                ++nt;
            }
        } else {
            const float a = chk_dot(OB + (size_t)row * D, p->in[I_WBR], D, col, D, ln), b = chk_dot(SB + (size_t)row * D, p->in[I_WBR] + (size_t)D * D, D, col, D, ln);
            const float ref = bf2f(GT[(size_t)row * 2048 + col]) * a + bf2f(GT[(size_t)row * 2048 + 1024 + col]) * b, got = bf2f(MX[(size_t)row * D + col]);
            if (fabsf(ref - got) > 0.03f * (fabsf(ref) + 0.3f)) ++nb;
            ++nt;
        }
    }
#ifdef CHK4_ROWWISE
    if (ln == 0) { atomicMax(dbg + 1 + 2 * which, nb); if (nb) atomicAdd(dbg + 9, 1u); }
#else
    if (ln == 0) { if (nb) atomicAdd(dbg + 1 + 2 * which, nb); atomicAdd(dbg + 2 + 2 * which, nt); }
#endif
    __syncthreads();
}
#endif
#ifndef MX_MASK
#define MX_MASK 15
#endif
#ifndef ATTN_REPS
#define ATTN_REPS 1
#endif
#ifndef UP_REPS
#define UP_REPS 1
#endif
#ifndef SP_REPS
#define SP_REPS 1
#endif
#ifndef SA_REPS
#define SA_REPS 1
#endif
#ifndef PRO_REPS
#define PRO_REPS 1
#endif
#ifndef NORM_REPS
#define NORM_REPS 1
#endif
__device__ __forceinline__ void mixer_phase(KP p, LAS unsigned char* lds, int vcu) {
    const int lane = tid_opaque() & 63;
    unsigned char* ws = p->ws;
    bf16_t* Q = (bf16_t*)(ws + WS_Q); const bf16_t* KB = (const bf16_t*)(ws + WS_KB); const bf16_t* VB = (const bf16_t*)(ws + WS_VB);
#if defined(SELFCHK) || defined(O_SEPARATE)
    bf16_t* OB = (bf16_t*)(ws + WS_O2);
#else
    bf16_t* OB = Q;
#endif
    bf16_t* U = (bf16_t*)(ws + WS_U); const bf16_t* GV = (const bf16_t*)(ws + WS_GV); const float* SSQ = (const float*)(ws + WS_SSQ);
    const float* lq = p->in[I_LQK];
    const float d1 = wave_sum(lq[lane] * lq[64 + lane]), d2 = wave_sum(lq[128 + lane] * lq[192 + lane]);
    const float lam = expf(d1) - expf(d2) + 0.2f;
    const float gqm = wave_max(fabsf(p->in[I_QG][lane])), gkm = wave_max(fabsf(p->in[I_KG][lane]));
    const float M2 = 8.f * gqm * gkm * 1.02f * LOG2E;
    if (MX_MASK & 1) { const int bh = vcu >> 2; for (int r_ = 0; r_ < SA_REPS; ++r_) sample_attn_unit(p, Q, (r_ + 1 < SA_REPS) ? (bf16_t*)(ws + 840 * MiB) : OB, bh >> 3, bh & 7, vcu & 3, lam, lds); }
    if ((MX_MASK & 2) && (vcu & 3) == 1 && (vcu >> 2) < 8) sample_spatial_unit(GV, U, SSQ, p->in[I_VNG], p->in[I_GWS], p->in[I_GBS], p->out + O_GS, vcu >> 2, lds);
    if (MX_MASK & 4) for (int r_ = 0; r_ < SP_REPS; ++r_) for (int ci = vcu; ci < MP / 128; ci += 256) spatial_unit(GV, U, SSQ, p->in[I_VNG], p->in[I_GWS], p->in[I_GBS], ci, lds, ws + WS_WF, p->ws + WS_END + 32768, (r_ + 1 < SP_REPS) ? (bf16_t*)(ws + 840 * MiB) : nullptr);
    __syncthreads();
    if (MX_MASK & 8) {
        const int b = vcu >> 5, pp = vcu & 31;
#pragma unroll 1
        for (int rep_ = 0; rep_ < ATTN_REPS; ++rep_)
#pragma unroll 1
        for (int h = 7; h >= 0; --h) {
            const float win = (2.f * M2 + 46.f) / ldexpf(LOG2E, -(h + 1));
            int ph = (pp + (int)((0x4a6d64a3dcULL >> (5 * h)) & 31)) & 31; if ((0x66 >> h) & 1) ph = 31 - ph;
            bf16_t* Od = (rep_ + 1 < ATTN_REPS) ? (bf16_t*)(ws + 840 * MiB) : OB;
            attn_unit(Q, KB, VB, Od, p->in[I_SUBG], b, h, 63 - ph, lds, lam, M2, win);
            attn_unit(Q, KB, VB, Od, p->in[I_SUBG], b, h, ph, lds, lam, M2, win);
        }
    }
}

#define RLX_AGENT __ATOMIC_RELAXED, __HIP_MEMORY_SCOPE_AGENT
#ifndef FENCE_SCOPE
#define FENCE_SCOPE ""
#endif
#define XB_TMO      128
#define XB_XCNT(j)  (256  + 64 * (j))
#define XB_XSUB(j)  (1280 + 64 * (j))
#define XB_XGEN(j)  (2304 + 64 * (j))
#define XB_TOP      3328
#define XB_TOPGEN   3392
#define XCD_BAR_WORDS 3456
#define XB_SPIN_CAP (1u << 18)

__device__ __forceinline__ unsigned xb_ld(unsigned* p)              { return __hip_atomic_load(p, __ATOMIC_RELAXED, __HIP_MEMORY_SCOPE_AGENT); }
__device__ __forceinline__ unsigned xb_add(unsigned* p, unsigned v) { return __hip_atomic_fetch_add(p, v, __ATOMIC_RELAXED, __HIP_MEMORY_SCOPE_AGENT); }
__device__ __forceinline__ unsigned xb_xcc_id() { return (unsigned)__builtin_amdgcn_s_getreg((3 << 11) | 20) & 0xFu; }
#define XB_SPIN(cond, bar) do { unsigned _sp = 0; while (cond) { __builtin_amdgcn_s_sleep(1); \
    if ((++_sp & 255u) == 0u) { if (xb_ld(&(bar)[XB_TMO])) break; if (_sp > XB_SPIN_CAP) { atomicAdd(&(bar)[XB_TMO], 1u); break; } } } } while (0)

struct XcdBarrier {
    unsigned* bar; unsigned x;
    volatile LAS unsigned* st;
};

__device__ __forceinline__ XcdBarrier xcd_barrier_post(unsigned* bar, volatile LAS unsigned* st) {
    XcdBarrier b; b.bar = bar; b.x = xb_xcc_id(); b.st = st;
    if (threadIdx.x == 0) (void)xb_add(&bar[XB_XCNT(b.x)], 1u);
    return b;
}
__device__ __forceinline__ void xcd_barrier_complete(unsigned* bar, unsigned x, unsigned& nloc, unsigned& nx) {
    const unsigned G = gridDim.x * gridDim.y * gridDim.z;
    unsigned sum, cnt, mine, sp = 0u;
    for (;;) {
        sum = 0u; cnt = 0u; mine = 0u;
#pragma unroll
        for (unsigned j = 0; j < 16; ++j) { const unsigned c = xb_ld(&bar[XB_XCNT(j)]); sum += c; cnt += (c > 0u) ? 1u : 0u; mine = (j == x) ? c : mine; }
        if (sum == G) break;
        __builtin_amdgcn_s_sleep(1);
        if ((++sp & 255u) == 0u) { if (xb_ld(&bar[XB_TMO])) break; if (sp > XB_SPIN_CAP) { atomicAdd(&bar[XB_TMO], 1u); break; } }
    }
    nloc = mine > 0u ? mine : 1u; nx = cnt > 0u ? cnt : 1u;
}

__device__ __forceinline__ void xcd_barrier(const XcdBarrier& b) {
    asm volatile("s_waitcnt vmcnt(0)" ::: "memory");
    __syncthreads();
    if (threadIdx.x == 0) {
        unsigned* bar = b.bar;
        __builtin_amdgcn_s_waitcnt(0);
        unsigned nloc = b.st[0], nx = b.st[1];
        if (nloc == 0u) { xcd_barrier_complete(bar, b.x, nloc, nx); b.st[0] = nloc; b.st[1] = nx; }
        const unsigned old = xb_add(&bar[XB_XSUB(b.x)], 1u);
        const unsigned gen = old / nloc;
        if (old + 1u == (gen + 1u) * nloc) {
            __builtin_amdgcn_fence(__ATOMIC_RELEASE, FENCE_SCOPE);
            asm volatile("s_waitcnt vmcnt(0)" ::: "memory");
            const unsigned og = xb_add(&bar[XB_TOP], 1u);
            const unsigned tg = og / nx;
            if (og + 1u == (tg + 1u) * nx) xb_add(&bar[XB_TOPGEN], 1u);
            else XB_SPIN(xb_ld(&bar[XB_TOPGEN]) == tg, bar);
            __builtin_amdgcn_fence(__ATOMIC_ACQUIRE, FENCE_SCOPE);
            xb_add(&bar[XB_XGEN(b.x)], 1u);
            asm volatile("s_waitcnt vmcnt(0)" ::: "memory");
        } else {
            XB_SPIN(xb_ld(&bar[XB_XGEN(b.x)]) == gen, bar);
            __builtin_amdgcn_fence(__ATOMIC_ACQUIRE, FENCE_SCOPE);
            asm volatile("s_waitcnt vmcnt(0)" ::: "memory");
        }
    }
    __syncthreads();
}

constexpr size_t WS_BAR = WS_END;
constexpr size_t WS_BAR_BYTES = 65536, WS_TOTAL = WS_BAR + WS_BAR_BYTES;
constexpr int LDS_XB = 139264;
__device__ __forceinline__ void seam_barrier(const XcdBarrier& b) {
#ifdef HEAVY_SEAM
    asm volatile("s_waitcnt vmcnt(0)\n\tbuffer_wbl2 sc0 sc1\n\ts_waitcnt vmcnt(0)\n\tbuffer_inv sc0 sc1\n\ts_waitcnt vmcnt(0)" ::: "memory");
#endif
    xcd_barrier(b);
#ifdef HEAVY_SEAM
    asm volatile("buffer_inv sc0 sc1\n\ts_waitcnt vmcnt(0)" ::: "memory");
    __syncthreads();
#endif
}
__device__ __forceinline__ void grid_barrier(cg::grid_group& grid) {
    asm volatile("s_waitcnt vmcnt(0)" ::: "memory");
    __syncthreads();
    if (threadIdx.x < 64) { __builtin_amdgcn_fence(__ATOMIC_RELEASE, FENCE_SCOPE); asm volatile("s_waitcnt vmcnt(0)" ::: "memory"); }
    grid.sync();
    __builtin_amdgcn_fence(__ATOMIC_ACQUIRE, FENCE_SCOPE);
    asm volatile("s_waitcnt vmcnt(0)" ::: "memory");
}
#if defined(SELFCHK) || defined(O_SEPARATE)
constexpr size_t WS_OSRC = WS_O2;
#else
constexpr size_t WS_OSRC = WS_Q;
#endif
#ifndef PH_MASK
#define PH_MASK 0xFFFF
#endif
#ifndef CHK_ITERS
#define CHK_ITERS 4
#endif
#ifndef CHK5_M0
#define CHK5_M0 0
#define CHK5_M1 6
#endif
#ifndef CHK4_REPORT
#define CHK4_REPORT (1000.f * (1.f + (float)nbad / 16.f))
#endif
#ifndef CHK4_ROWS
#define CHK4_ROWS MP
#endif
#ifndef CHK4_ROW0
#define CHK4_ROW0 0
#endif
#ifndef CHK4_WHICH
#define CHK4_WHICH 0
#endif
#ifndef CHK3_ROWS
#define CHK3_ROWS MP
#endif
#ifndef CHK_ATT_ITERS
#define CHK_ATT_ITERS CHK_ITERS
#endif
#ifndef CHK_REPORT
#define CHK_REPORT (1000.f + 100000.f * (float)nbad / (float)(ntot + 1))
#endif
#ifndef CHK_OFF
#define CHK_OFF(o) ((o) & 60)
#endif
#ifndef CHK_FILTER
#define CHK_FILTER
#endif
#ifndef STEP_LIMIT
#define STEP_LIMIT 13
#endif
__global__ void __launch_bounds__(512, 2) fwd_megakernel(Params p_unused) {
    extern __shared__ __attribute__((aligned(16))) unsigned char lds_raw[];
    LAS unsigned char* lds = (LAS unsigned char*)lds_raw;
    cg::grid_group grid = cg::this_grid();
    if (threadIdx.x < 2) ((volatile LAS unsigned*)(lds + LDS_XB))[threadIdx.x] = 0u;
    __syncthreads();
    const XcdBarrier xbar = xcd_barrier_post((unsigned*)(kparams()->ws + WS_BAR), (volatile LAS unsigned*)(lds + LDS_XB));
    grid.sync();
    const int G0 = gridDim.x, bx0 = blockIdx.x;
    const int vcu0 = (G0 % 8 == 0) ? (bx0 % 8) * (G0 / 8) + bx0 / 8 : bx0;
#pragma unroll 1
    for (int step = 0; step < 14; ++step) {
        const KP kp = kparams();
        if (step > STEP_LIMIT && step != 13) { seam_barrier(xbar); continue; }
        int G = G0, bx = bx0, vcu = vcu0; asm volatile("" : "+s"(G), "+s"(bx), "+s"(vcu));
        if (step == 0 && (PH_MASK & 1)) {
            for (int r_ = 0; r_ < PRO_REPS; ++r_) { prologue(kp, lds, vcu, G); __syncthreads(); }
        } else if ((step == 1 || step == 4 || step == 10 || step == 13) && (PH_MASK & 2)) {
            for (int r_ = 0; r_ < ((step == 13) ? 1 : NORM_REPS); ++r_) norm_rows(kp, step == 1 ? 0 : step == 4 ? 1 : step == 10 ? 2 : 3, vcu, G);
        } else if ((step == 2 || step == 11) && (PH_MASK & 4)) {
#pragma unroll 1
            for (int part = 0; part < 2 * UP_REPS; ++part) {
                unsigned char* ws = kp->ws; const int roff = (part & 1) ? MP : 0;
                pg8::Gemm g{(const bf16_t*)(ws + WS_HN) + (size_t)roff * D, (const bf16_t*)(ws + (step == 2 ? WS_WGU1 : WS_WGU2)), (part & 1) ? 256 : MP, 2 * DFF, D};
                pg8::StaticOrder S; S.init((part & 1) ? 256 : MP, 2 * DFF, G, bx);
                EpiUp E{kp, roff};
                if (part) pg8::gemm_phase<EpiUp, pg8::StaticOrder, true, true, true>(lds, g, S, E); else pg8::gemm_phase<EpiUp, pg8::StaticOrder, true, true, false>(lds, g, S, E);
            }
#ifdef SELFCHK4
            if (step == 2) { seam_barrier(xbar); check_gemms(kp, 2, vcu, G); }
#endif
#ifdef SELFCHK5
            if (step == SELFCHK5) {
                seam_barrier(xbar);
                unsigned char* ws5 = kp->ws; unsigned nb5 = 0; const int t5 = tid_opaque();
                const float* srcs[6] = {kp->in[I_WGATE], kp->in[I_WBR], kp->in[I_WBR] + (size_t)D * D, kp->in[I_WOUT], kp->in[I_WD1], kp->in[I_WD2]};
                const size_t offs[6] = {WS_WGT, WS_WBA, WS_WBB, WS_WOUT, WS_WD1, WS_WD2};
                const int Ns[6] = {2048, D, D, D, D, D}, Ks[6] = {D, D, D, D, DFF, DFF};
                for (int mi = CHK5_M0; mi < CHK5_M1; ++mi) {
                    const bf16_t* WT = (const bf16_t*)(ws5 + offs[mi]); const float* W = srcs[mi]; const int N5 = Ns[mi], K5 = Ks[mi];
                    for (size_t e = (size_t)vcu * 512 + t5; e < (size_t)N5 * K5; e += (size_t)G * 512) {
                        const int n = (int)(e / K5), k = (int)(e % K5);
                        if (WT[e] != f2bf(W[(size_t)k * N5 + n])) ++nb5;
                    }
                }
                if (nb5) atomicAdd((unsigned*)(ws5 + WS_END + 32768) + 1, nb5);
                __syncthreads();
            }
#endif
        } else if ((step == 3 || step == 12 || step == 9) && (PH_MASK & 8)) {
#pragma unroll 1
            for (int part = 0; part < 2; ++part) {
                unsigned char* ws = kp->ws; const int roff = part ? MP : 0; const int K = step == 9 ? D : DFF;
                pg8::Gemm g{(const bf16_t*)(ws + (step == 9 ? WS_MIXED : WS_HID)) + (size_t)roff * K, (const bf16_t*)(ws + (step == 3 ? WS_WD1 : step == 12 ? WS_WD2 : WS_WOUT)), part ? 256 : MP, D, K};
                pg8::StaticOrder S; S.init(part ? 256 : MP, D, G, bx);
                EpiRes E{kp, step == 3 ? 2 : step == 9 ? 5 : 8, step == 9 ? 1.f : 0.5f, step == 3 ? 1 : 0, roff};
                if (part) pg8::gemm_phase<EpiRes, pg8::StaticOrder, true, true, true>(lds, g, S, E); else pg8::gemm_phase<EpiRes, pg8::StaticOrder, true, true, false>(lds, g, S, E);
            }
        } else if (step == 5 && (PH_MASK & 16)) {
#pragma unroll 1
            for (int part = 0; part < 2; ++part) {
                unsigned char* ws = kp->ws; const int roff = part ? MP : 0;
                pg8::Gemm g{(const bf16_t*)(ws + WS_HN2) + (size_t)roff * D, (const bf16_t*)(ws + WS_WIN), part ? 256 : MP, 5120, D};
                pg8::StaticOrder S; S.init(part ? 256 : MP, 5120, G, bx);
                EpiIn E{kp, roff};
                if (part) pg8::gemm_phase<EpiIn, pg8::StaticOrder, true, true, true>(lds, g, S, E); else pg8::gemm_phase<EpiIn, pg8::StaticOrder, true, true, false>(lds, g, S, E);
            }
        } else if (step == 6 && (PH_MASK & 32)) {
            mixer_phase(kp, lds, vcu);
        } else if (step == 7 && (PH_MASK & 64)) {
#ifdef SELFCHK3
            {
                const bf16_t* OB = (const bf16_t*)(kp->ws + WS_Q); const int tid3 = tid_opaque(), ln = tid3 & 63, wv = tid3 >> 6;
                unsigned nb = 0;
                for (int row = vcu * 8 + wv; row < CHK3_ROWS; row += G * 8) {
                    for (int hh = 0; hh < 8; ++hh) {
                        const unsigned w = *(const unsigned*)(OB + (size_t)row * D + hh * 128 + 2 * ln);
                        const float a = bf_lo(w), b = bf_hi(w);
                        const float ms = wave_sum(a * a + b * b) * (1.f / 128.f);
                        if (!(ms > 0.3f && ms < 1.2f)) ++nb;
                    }
                }
                if (ln == 0 && nb) atomicAdd((unsigned*)(kp->ws + WS_END + 32768) + 1, nb);
                __syncthreads();
                seam_barrier(xbar);
            }
#endif
#pragma unroll 1
            for (int part = 0; part < 2; ++part) {
                unsigned char* ws = kp->ws; const int roff = part ? MP : 0;
                pg8::Gemm g{(const bf16_t*)(ws + WS_HN2) + (size_t)roff * D, (const bf16_t*)(ws + WS_WGT), part ? 256 : MP, 2048, D};
                pg8::StaticOrder S; S.init(part ? 256 : MP, 2048, G, bx);
                EpiGates E{kp, roff};
                if (part) pg8::gemm_phase<EpiGates, pg8::StaticOrder, true, true, true>(lds, g, S, E); else pg8::gemm_phase<EpiGates, pg8::StaticOrder, true, true, false>(lds, g, S, E);
            }
#ifdef SELFCHK4
            seam_barrier(xbar); check_gemms(kp, 0, vcu, G);
#endif
        } else if (step == 8 && (PH_MASK & 128)) {
#pragma unroll 1
            for (int hp = 0; hp < 4; ++hp) {
                const int half = hp & 1, part = hp >> 1;
                unsigned char* ws = kp->ws; const int roff = part ? MP : 0;
                pg8::Gemm g{(const bf16_t*)(ws + (half ? WS_U : WS_Q)) + (size_t)roff * D, (const bf16_t*)(ws + (half ? WS_WBB : WS_WBA)), part ? 256 : MP, D, D};
                pg8::StaticOrder S; S.init(part ? 256 : MP, D, G, bx);
                EpiBr E{kp, half * D, half, roff};
                if (part) pg8::gemm_phase<EpiBr, pg8::StaticOrder, true, true, true>(lds, g, S, E); else pg8::gemm_phase<EpiBr, pg8::StaticOrder, true, true, false>(lds, g, S, E);
            }
#ifdef SELFCHK4
            seam_barrier(xbar); check_gemms(kp, 1, vcu, G);
#endif
        }
#if defined(SELFCHK4) || defined(SELFCHK5)
        if (step == 13 && bx0 == 0 && threadIdx.x == 0) { unsigned* dbg = (unsigned*)(kp->ws + WS_END + 32768); const unsigned nbad = __hip_atomic_load(dbg + 1 + 2 * CHK4_WHICH, __ATOMIC_RELAXED, __HIP_MEMORY_SCOPE_AGENT); kp->out[1] = CHK4_REPORT; }
#endif
#ifdef SELFCHK3
        if (step == 13 && bx0 == 0 && threadIdx.x == 0) { const unsigned nbad = __hip_atomic_load((unsigned*)(kp->ws + WS_END + 32768) + 1, __ATOMIC_RELAXED, __HIP_MEMORY_SCOPE_AGENT); kp->out[1] = 1000.f * (1.f + (float)nbad / 16.f); }
#endif
#ifdef SELFCHK
        if (step == 13 && bx0 == 0 && threadIdx.x == 0) { const float rel = __uint_as_float(__hip_atomic_load((unsigned*)(kp->ws + WS_DBG), __ATOMIC_RELAXED, __HIP_MEMORY_SCOPE_AGENT)); const unsigned nbad = __hip_atomic_load((unsigned*)(kp->ws + WS_DBG) + 1, __ATOMIC_RELAXED, __HIP_MEMORY_SCOPE_AGENT), ntot = __hip_atomic_load((unsigned*)(kp->ws + WS_DBG) + 2, __ATOMIC_RELAXED, __HIP_MEMORY_SCOPE_AGENT);
            kp->out[1] = CHK_REPORT; }
#endif
        if (step < 13) seam_barrier(xbar);
    }
}

extern "C" void kernel_launch(void* const* d_in, const int* in_sizes, int n_in, void* d_out, int out_size, void* d_ws, size_t ws_size, hipStream_t stream) {
    static int grid = 0;
    if (grid == 0) {
        if (n_in != 25 || (size_t)out_size != O_END || ws_size < WS_TOTAL) { fprintf(stderr, "kernel_launch: unexpected shapes (n_in %d out %d ws %zu)\n", n_in, out_size, ws_size); grid = -1; return; }
        int dev = 0, cus = 0, per_cu = 0;
        hipGetDevice(&dev);
        hipDeviceGetAttribute(&cus, hipDeviceAttributeMultiprocessorCount, dev);
        if (hipFuncSetAttribute((const void*)fwd_megakernel, hipFuncAttributeMaxDynamicSharedMemorySize, LDS_BYTES) != hipSuccess) { fprintf(stderr, "kernel_launch: hipFuncSetAttribute failed\n"); grid = -1; return; }
        if (hipOccupancyMaxActiveBlocksPerMultiprocessor(&per_cu, (const void*)fwd_megakernel, 512, LDS_BYTES) != hipSuccess || per_cu < 1) { fprintf(stderr, "kernel_launch: occupancy query says %d\n", per_cu); per_cu = 1; }
        (void)hipGetLastError();
        grid = cus * per_cu;
    }
    if (grid < 0) return;
    if (hipMemsetAsync((char*)d_ws + WS_BAR, 0, WS_BAR_BYTES, stream) != hipSuccess) { fprintf(stderr, "kernel_launch: memset failed\n"); return; }
    Params p{};
    for (int i = 0; i < 25; ++i) p.in[i] = (const float*)d_in[i];
    p.out = (float*)d_out; p.ws = (unsigned char*)d_ws;
    void* args[] = {&p};
    hipError_t e = hipLaunchCooperativeKernel((const void*)fwd_megakernel, dim3(grid), dim3(512), args, LDS_BYTES, stream);
    if (e != hipSuccess) fprintf(stderr, "cooperative launch failed: %s (grid %d)\n", hipGetErrorString(e), grid);
}
```

```cpp
#include <hip/hip_runtime.h>
#include <hip/hip_cooperative_groups.h>
#include <cstdio>
#include <cstdint>
namespace cg = cooperative_groups;
namespace pg8 {
#define PG8_LAS __attribute__((address_space(3)))
typedef unsigned short bf16_t;
typedef short bf16x8 __attribute__((ext_vector_type(8)));
typedef float f32x4 __attribute__((ext_vector_type(4)));
typedef unsigned u32x4 __attribute__((ext_vector_type(4)));
constexpr int BM = 256, BK = 64, HALF = 128, HTB = HALF * BK * 2  , STAGE_BYTES = 8 * HTB, NXCD = 8, WGM = 8;

__host__ __device__ __forceinline__ int lds_byte(int r, int c) { const int st = (r >> 4) * 2 + (c >> 5), rr = r & 15, cc = c & 31, ob = rr * 64 + cc * 2; return st * 1024 + (ob ^ (((ob >> 9) & 1) << 5)); }
__host__ __device__ __forceinline__ void stage_rc(int b, int& R, int& C) { const int st = b / 1024, sb = b % 1024, swz = sb ^ (((sb >> 9) & 1) << 5); R = (st >> 1) * 16 + swz / 64; C = (st & 1) * 32 + (swz % 64) / 2; }
__host__ __device__ __forceinline__ int perm32(int rho) { const int n = rho >> 4, i = rho & 15; return 8 * (i >> 2) + 4 * n + (i & 3); }

struct Unit { int pm, pn; };
struct Gemm { const bf16_t* A; const bf16_t* Bt; int M, N, K; };

struct StaticOrder {
    int nM, nN, nwg, G, c;
    __host__ __device__ void init(int M, int N, int G_, int c_) { nM = M / BM; nN = N / BM; nwg = nM * nN; G = G_; c = c_; }
    __host__ __device__ bool next(int i, Unit& u) const {
        const long L = (long)i * G + c; if (L >= nwg) return false;
        int wgid = (int)L; { const int q = nwg / NXCD, r = nwg % NXCD, xcd = wgid % NXCD, off = wgid / NXCD; wgid = (xcd < r ? xcd * (q + 1) : r * (q + 1) + (xcd - r) * q) + off; }
        const int nig = WGM * nN, gid = wgid / nig, fm = gid * WGM, gsz = (nM - fm) < WGM ? (nM - fm) : WGM;
        u.pm = fm + ((wgid % nig) % gsz); u.pn = (wgid % nig) / gsz; return true;
    }
    __device__ __forceinline__ void a_ready(const Unit&) const {}
    __device__ __forceinline__ void done(const Unit&) const {}
};
__device__ __forceinline__ unsigned cvt_pk_bf16(float lo, float hi) { unsigned r; asm volatile("v_cvt_pk_bf16_f32 %0, %1, %2" : "=v"(r) : "v"(lo), "v"(hi)); return r; }
template <class Epi, class Sched, bool ALIGN_EPI = false, bool SP2 = false, bool HALF_M = false>
__device__ __forceinline__ void gemm_phase(PG8_LAS unsigned char* lds, const Gemm g, const Sched& S, const Epi& E) {
    int tid_ = threadIdx.x; asm volatile("" : "+v"(tid_));
    const int tid = tid_, wid = __builtin_amdgcn_readfirstlane(tid >> 6), lane = tid & 63, wr = wid >> 2, wc = wid & 3, fr = lane & 15, fq = lane >> 4;
    const int K = g.K, nt = K / BK;
    unsigned voffA[2], voffB[2];
#pragma unroll
    for (int i = 0; i < 2; ++i) { int R, C; stage_rc(tid * 16 + i * 8192, R, C); const int Rb = Epi::PERM ? ((R & ~31) + perm32(R & 31)) : R;
        voffA[i] = (unsigned)(R * K + C) * 2u; voffB[i] = (unsigned)(Rb * K + C) * 2u; }
    const size_t kstep = (size_t)(BK * 2);
    const size_t hstep = (size_t)HALF * K * 2;
    const size_t tstep = 2 * hstep;
    const unsigned ldsw = (unsigned)wid * 1024u;
    const int aoff = lds_byte(wr * 64 + fr, fq * 8), boff = lds_byte(wc * 32 + fr, fq * 8);
#define PG8_SA(b, h) (((b) * 2 + (h)) * HTB)
#define PG8_SB(b, h) ((4 + (b) * 2 + (h)) * HTB)
#define PG8_STAGE(bufoff, gbase, voff) do { _Pragma("unroll") for (int _i = 0; _i < 2; ++_i) \
        __builtin_amdgcn_global_load_lds((const unsigned*)((const char*)(gbase) + (voff)[_i]), (PG8_LAS unsigned*)(lds + (bufoff) + ldsw + _i * 8192), 16, 0, 0); } while (0)
#define PG8_LDA(dst, b, h) do { _Pragma("unroll") for (int m = 0; m < 4; ++m) _Pragma("unroll") for (int k = 0; k < 2; ++k) dst[m][k] = *(const PG8_LAS bf16x8*)(lds + PG8_SA(b, h) + aoff + m * 2048 + k * 1024); } while (0)
#define PG8_LDB(dst, b, h) do { _Pragma("unroll") for (int n = 0; n < 2; ++n) _Pragma("unroll") for (int k = 0; k < 2; ++k) dst[n][k] = *(const PG8_LAS bf16x8*)(lds + PG8_SB(b, h) + boff + n * 2048 + k * 1024); } while (0)
#define PG8_MMA(ai, bj, At, Bt) do { __builtin_amdgcn_s_setprio(1); _Pragma("unroll") for (int m = 0; m < 4; ++m) _Pragma("unroll") for (int n = 0; n < 2; ++n) _Pragma("unroll") for (int k = 0; k < 2; ++k) \
        acc[ai][bj][m][n] = __builtin_amdgcn_mfma_f32_16x16x32_bf16(Bt[n][k], At[m][k], acc[ai][bj][m][n], 0, 0, 0); __builtin_amdgcn_s_setprio(0); } while (0)
#define PG8_WAIT_V(n) asm volatile("s_waitcnt vmcnt(" #n ")" ::: "memory")
#define PG8_WAIT_L(n) asm volatile("s_waitcnt lgkmcnt(" #n ")" ::: "memory")
#define PG8_BAR __builtin_amdgcn_s_barrier()
#define PG8_SCHED __builtin_amdgcn_sched_barrier(0)
    Unit cur, nxt; int ui = 0;
    if (!S.next(0, cur)) return;
    f32x4 acc[2][2][4][2];
#pragma unroll
    for (int a = 0; a < 2; ++a)
#pragma unroll
        for (int b = 0; b < 2; ++b)
#pragma unroll
            for (int m = 0; m < 4; ++m)
#pragma unroll
                for (int n = 0; n < 2; ++n) acc[a][b][m][n] = (f32x4){0.f, 0.f, 0.f, 0.f};
    bf16x8 At[4][2], B0[2][2], B1[2][2];
    const char* cA = (const char*)g.A + (size_t)cur.pm * tstep; const char* cB = (const char*)g.Bt + (size_t)cur.pn * tstep;
    S.a_ready(cur);
    if constexpr (SP2) {
        PG8_STAGE(PG8_SB(0, 0), cB, voffB); PG8_STAGE(PG8_SB(0, 1), cB + hstep, voffB); PG8_STAGE(PG8_SA(0, 0), cA, voffA); PG8_STAGE(PG8_SA(0, 1), cA + hstep, voffA);
        if (wr == 1) PG8_BAR;
        PG8_WAIT_V(2); PG8_BAR;
        PG8_STAGE(PG8_SB(1, 0), cB + kstep, voffB); PG8_STAGE(PG8_SA(1, 0), cA + kstep, voffA); PG8_STAGE(PG8_SB(1, 1), cB + hstep + kstep, voffB);
        PG8_WAIT_V(6); PG8_BAR;
    } else {
        PG8_STAGE(PG8_SB(0, 0), cB, voffB); PG8_STAGE(PG8_SA(0, 0), cA, voffA); PG8_STAGE(PG8_SB(0, 1), cB + hstep, voffB); PG8_STAGE(PG8_SA(0, 1), cA + hstep, voffA);
        if (wr == 1) PG8_BAR;
        PG8_WAIT_V(4); PG8_BAR;
        PG8_STAGE(PG8_SB(1, 0), cB + kstep, voffB); PG8_STAGE(PG8_SA(1, 0), cA + kstep, voffA); PG8_STAGE(PG8_SB(1, 1), cB + hstep + kstep, voffB);
        PG8_WAIT_V(6); PG8_BAR;
    }
    for (;;) {
        const bool has_next = S.next(ui + 1, nxt);
        const char* nA = has_next ? (const char*)g.A + (size_t)nxt.pm * tstep : cA; const char* nB = has_next ? (const char*)g.Bt + (size_t)nxt.pn * tstep : cB;
        for (int t = 0; t < nt; t += 2) {
            const bool last = (t == nt - 2);
            const char* a1 = cA + (size_t)(t + 1) * kstep;
            const char* a2 = last ? nA : cA + (size_t)(t + 2) * kstep; const char* b2 = last ? nB : cB + (size_t)(t + 2) * kstep;
            const char* a3 = a2 + kstep; const char* b3 = b2 + kstep;
            if (last && has_next) S.a_ready(nxt);
            if constexpr (SP2) {
            PG8_LDB(B0, 0, 0); PG8_LDB(B1, 0, 1); PG8_SCHED; PG8_LDA(At, 0, 0); PG8_STAGE(PG8_SA(1, 1), a1 + hstep, voffA);
            PG8_WAIT_V(8); PG8_WAIT_L(0); PG8_BAR; PG8_MMA(0, 0, At, B0); PG8_MMA(0, 1, At, B1); PG8_BAR; PG8_SCHED;
            if constexpr (!HALF_M) { PG8_LDA(At, 0, 1); } PG8_STAGE(PG8_SB(0, 0), b2, voffB); PG8_STAGE(PG8_SB(0, 1), b2 + hstep, voffB); PG8_STAGE(PG8_SA(0, 0), a2, voffA);
            PG8_WAIT_V(8); PG8_WAIT_L(0); PG8_BAR; if constexpr (!HALF_M) { PG8_MMA(1, 0, At, B0); PG8_MMA(1, 1, At, B1); } PG8_BAR; PG8_SCHED;
            PG8_LDB(B0, 1, 0); PG8_LDB(B1, 1, 1); PG8_SCHED; PG8_LDA(At, 1, 0); PG8_STAGE(PG8_SA(0, 1), a2 + hstep, voffA);
            PG8_WAIT_V(8); PG8_WAIT_L(0); PG8_BAR; PG8_MMA(0, 0, At, B0); PG8_MMA(0, 1, At, B1); PG8_BAR; PG8_SCHED;
            if constexpr (!HALF_M) { PG8_LDA(At, 1, 1); } PG8_STAGE(PG8_SB(1, 0), b3, voffB); PG8_STAGE(PG8_SB(1, 1), b3 + hstep, voffB); PG8_STAGE(PG8_SA(1, 0), a3, voffA);
            PG8_WAIT_V(8); PG8_WAIT_L(0); PG8_BAR; if constexpr (!HALF_M) { PG8_MMA(1, 0, At, B0); PG8_MMA(1, 1, At, B1); } PG8_BAR; PG8_SCHED;
            } else {
            PG8_LDB(B0, 0, 0); PG8_SCHED; PG8_LDA(At, 0, 0); PG8_STAGE(PG8_SA(1, 1), a1 + hstep, voffA);
            PG8_WAIT_L(8); PG8_BAR; PG8_WAIT_L(0); PG8_MMA(0, 0, At, B0); PG8_BAR; PG8_SCHED;
            PG8_LDB(B1, 0, 1); PG8_STAGE(PG8_SB(0, 0), b2, voffB);
            PG8_BAR; PG8_WAIT_L(0); PG8_MMA(0, 1, At, B1); PG8_BAR;
            PG8_LDA(At, 0, 1); PG8_STAGE(PG8_SA(0, 0), a2, voffA);
            PG8_BAR; PG8_WAIT_L(0); PG8_MMA(1, 0, At, B0); PG8_BAR; PG8_SCHED;
            PG8_STAGE(PG8_SB(0, 1), b2 + hstep, voffB);
            PG8_WAIT_V(6); PG8_BAR; PG8_MMA(1, 1, At, B1); PG8_BAR;
            PG8_LDB(B0, 1, 0); PG8_SCHED; PG8_LDA(At, 1, 0); PG8_STAGE(PG8_SA(0, 1), a2 + hstep, voffA);
            PG8_WAIT_L(8); PG8_BAR; PG8_WAIT_L(0); PG8_MMA(0, 0, At, B0); PG8_BAR; PG8_SCHED;
            PG8_LDB(B1, 1, 1); PG8_STAGE(PG8_SB(1, 0), b3, voffB);
            PG8_BAR; PG8_WAIT_L(0); PG8_MMA(0, 1, At, B1); PG8_BAR;
            PG8_LDA(At, 1, 1); PG8_STAGE(PG8_SA(1, 0), a3, voffA);
            PG8_BAR; PG8_WAIT_L(0); PG8_MMA(1, 0, At, B0); PG8_BAR; PG8_SCHED;
            PG8_STAGE(PG8_SB(1, 1), b3 + hstep, voffB);
            PG8_WAIT_V(6); PG8_BAR; PG8_MMA(1, 1, At, B1); PG8_BAR;
            }
        }
        if constexpr (ALIGN_EPI) { if (wr == 0) PG8_BAR; }
        if constexpr (!Epi::AFTER_DRAIN) { E(acc, cur, wr, wc, fr, fq); S.done(cur); }
        if (!has_next) break;
#pragma unroll
        for (int a = 0; a < 2; ++a)
#pragma unroll
            for (int b = 0; b < 2; ++b)
#pragma unroll
                for (int m = 0; m < 4; ++m)
#pragma unroll
                    for (int n = 0; n < 2; ++n) acc[a][b][m][n] = (f32x4){0.f, 0.f, 0.f, 0.f};
        cur = nxt; cA = nA; cB = nB; ++ui;
        if constexpr (ALIGN_EPI) { if (wr == 1) PG8_BAR; }
    }
    PG8_WAIT_V(0);
    if constexpr (!ALIGN_EPI) { if (wr == 0) PG8_BAR; }
    PG8_BAR;
    if constexpr (Epi::AFTER_DRAIN) { E.fused(acc, cur, wr, wc, fr, fq, lds, wid, lane); S.done(cur); }
#undef PG8_SA
#undef PG8_SB
#undef PG8_STAGE
#undef PG8_LDA
#undef PG8_LDB
#undef PG8_MMA
#undef PG8_WAIT_V
#undef PG8_WAIT_L
#undef PG8_BAR
#undef PG8_SCHED
}
}

using pg8::bf16_t; using pg8::f32x4; using pg8::u32x4; using pg8::bf16x8;
typedef float f32x16 __attribute__((ext_vector_type(16)));
typedef short v4i16_t __attribute__((ext_vector_type(4)));
typedef unsigned u32x2 __attribute__((ext_vector_type(2)));
#define LAS __attribute__((address_space(3)))

constexpr int D = 1024, MP = 65536, MS = 128, MV = MP + MS, MT = 65792, DFF = 2816, TSEQ = 8192, NMOD = 9216;
constexpr float EPS = 1e-6f, LOG2E = 1.4426950408889634f;
constexpr size_t MiB = 1ull << 20;
constexpr size_t WS_WGU1 = 0, WS_WD1 = 11 * MiB, WS_WIN = 17 * MiB, WS_WGT = 27 * MiB, WS_WBA = 31 * MiB, WS_WBB = 33 * MiB,
                 WS_WOUT = 35 * MiB, WS_WGU2 = 37 * MiB, WS_WD2 = 48 * MiB, WS_MODS = 54 * MiB, WS_SSQ = 55 * MiB, WS_HN = 60 * MiB,
                 WS_R = 189 * MiB, WS_Q = WS_R, WS_KB = WS_R + 129 * MiB, WS_VB = WS_R + 258 * MiB, WS_U = WS_R + 387 * MiB,
                 WS_GV = WS_R + 516 * MiB, WS_END = WS_R + 645 * MiB;
constexpr size_t WS_HID = WS_R, WS_GATES = WS_KB, WS_MIXED = WS_GV;
constexpr size_t WS_WF = 59 * MiB + 65536;
static_assert(WS_SSQ + (size_t)16 * MT * 4 <= WS_WF && WS_WF + 8 * 4 * 8 * 64 * 16 <= WS_HN, "Wf slot");
#ifdef SEP_HN2
constexpr size_t WS_HN2 = 840 * MiB;
#else
constexpr size_t WS_HN2 = WS_HN;
#endif
static_assert((size_t)MT * D * 2 <= 129 * MiB && (size_t)MT * DFF * 2 <= 645 * MiB && (size_t)MT * 2048 * 2 <= 258 * MiB, "ws map");
constexpr size_t O_Y = 0, O_KP = (size_t)MV * D, O_VP = O_KP + (size_t)MP * D, O_KS = O_VP + (size_t)MP * D, O_VS = O_KS + (size_t)MS * D,
                 O_GS = O_VS + (size_t)MS * D, O_END = O_GS + (size_t)MS * D;
constexpr int LDS_BYTES = 139264 + 256;

struct Params { const float* in[25]; float* out; unsigned char* ws; };
typedef const __attribute__((address_space(4))) Params* KP;
__device__ __forceinline__ KP kparams() { KP k = (KP)__builtin_amdgcn_kernarg_segment_ptr(); asm volatile("" : "+s"(k)); return k; }
enum { I_XP = 0, I_XS, I_CK, I_CV, I_CP, I_CS, I_ADAW, I_ADAB, I_NORMG, I_WGU1, I_WD1, I_WIN, I_QG, I_KG, I_LQK, I_SUBG, I_VNG, I_GWS, I_GBS,
       I_WGATE, I_BGATE, I_WBR, I_WOUT, I_WGU2, I_WD2 };

typedef float f32x2_t __attribute__((ext_vector_type(2))); typedef __bf16 bf16x2_t __attribute__((ext_vector_type(2)));
__device__ __forceinline__ unsigned cvt_pk(float lo, float hi) { f32x2_t v = {lo, hi}; bf16x2_t b = __builtin_convertvector(v, bf16x2_t); return __builtin_bit_cast(unsigned, b); }
__device__ __forceinline__ u32x4 pack8(f32x4 a, f32x4 b) { u32x4 w; w.x = cvt_pk(a[0], a[1]); w.y = cvt_pk(a[2], a[3]); w.z = cvt_pk(b[0], b[1]); w.w = cvt_pk(b[2], b[3]); return w; }
__device__ __forceinline__ float bf_lo(unsigned w) { return __uint_as_float(w << 16); }
__device__ __forceinline__ float bf_hi(unsigned w) { return __uint_as_float(w & 0xffff0000u); }
__device__ __forceinline__ float bf2f(bf16_t h) { return __uint_as_float((unsigned)h << 16); }
__device__ __forceinline__ bf16_t f2bf(float f) { return (bf16_t)(cvt_pk(f, 0.f) & 0xffffu); }
__device__ __forceinline__ float fast_rcp(float x) { return __builtin_amdgcn_rcpf(x); }
__device__ __forceinline__ float sigmoidf_(float x) { return fast_rcp(1.f + __builtin_amdgcn_exp2f(-x * LOG2E)); }
__device__ __forceinline__ float siluf_(float x) { return x * sigmoidf_(x); }
__device__ __forceinline__ float geluf_(float x) { const float y = 0.7978845608028654f * (x + 0.044715f * x * x * x); return x * sigmoidf_(2.f * y); }
__device__ __forceinline__ f32x4 gelu4(f32x4 v) { return (f32x4){geluf_(v[0]), geluf_(v[1]), geluf_(v[2]), geluf_(v[3])}; }
__device__ __forceinline__ float wave_sum(float v) {
#pragma unroll
    for (int o = 1; o < 64; o <<= 1) v += __shfl_xor(v, o);
    return v;
}
__device__ __forceinline__ float wave_max(float v) {
#pragma unroll
    for (int o = 1; o < 64; o <<= 1) v = fmaxf(v, __shfl_xor(v, o));
    return v;
}
__device__ __forceinline__ int modidx(int row) { return row < MP ? (row >> 13) : (8 + ((row - MP) >> 4)); }
__device__ __forceinline__ int crow(int r, int hi) { return (r & 3) + 8 * (r >> 2) + 4 * hi; }
#define LDS_WAIT() asm volatile("s_waitcnt lgkmcnt(0)" ::: "memory")
__device__ __forceinline__ int tid_opaque() { int t = threadIdx.x; asm volatile("" : "+v"(t)); return t; }


#ifdef WT_STORES
__device__ __forceinline__ void st_wt(u32x4* p, u32x4 v) { asm volatile("global_store_dwordx4 %0, %1, off sc0 sc1" :: "v"(p), "v"(v) : "memory"); }
__device__ __forceinline__ void st_wt(f32x4* p, f32x4 v) { asm volatile("global_store_dwordx4 %0, %1, off sc0 sc1" :: "v"(p), "v"(v) : "memory"); }
__device__ __forceinline__ void st_wt(u32x2* p, u32x2 v) { asm volatile("global_store_dwordx2 %0, %1, off sc0 sc1" :: "v"(p), "v"(v) : "memory"); }
__device__ __forceinline__ void st_wt(float* p, float v) { asm volatile("global_store_dword %0, %1, off sc0 sc1" :: "v"(p), "v"(v) : "memory"); }
__device__ __forceinline__ void st_wt(bf16_t* p, bf16_t v) { const unsigned w = v; asm volatile("global_store_short %0, %1, off sc0 sc1" :: "v"(p), "v"(w) : "memory"); }
#else
template <class T> __device__ __forceinline__ void st_wt(T* p, T v) { *p = v; }
#endif
struct EpiUp {
    static constexpr bool PERM = true, AFTER_DRAIN = false;
    KP kp; int roff;
    __device__ __forceinline__ void operator()(const f32x4 (&acc)[2][2][4][2], const pg8::Unit& u, int wr, int wc, int fr, int fq) const {
        const int col = u.pn * 128 + wc * 32 + fq * 8; bf16_t* HID = (bf16_t*)(kp->ws + WS_HID);
#pragma unroll
        for (int ai = 0; ai < 2; ++ai)
#pragma unroll
            for (int m = 0; m < 4; ++m) {
                const int row = roff + u.pm * 256 + ai * 128 + wr * 64 + m * 16 + fr;
                f32x4 h0, h1;
#pragma unroll
                for (int i = 0; i < 4; ++i) { h0[i] = siluf_(acc[ai][0][m][0][i]) * acc[ai][1][m][0][i]; h1[i] = siluf_(acc[ai][0][m][1][i]) * acc[ai][1][m][1][i]; }
                st_wt((u32x4*)(HID + (size_t)row * DFF + col), pack8(h0, h1));
            }
    }
};
struct EpiRes {
    static constexpr bool PERM = true, AFTER_DRAIN = false;
    KP kp; int gi; float scale; int base_in; int roff;
    __device__ __forceinline__ void operator()(const f32x4 (&acc)[2][2][4][2], const pg8::Unit& u, int wr, int wc, int fr, int fq) const {
        const int c0 = u.pn * 256 + wc * 32 + fq * 8;
        const float* xp = kp->in[I_XP]; const float* xs = kp->in[I_XS]; float* X = kp->out + O_Y; const float* mods = (const float*)(kp->ws + WS_MODS);
#pragma unroll
        for (int ai = 0; ai < 2; ++ai)
#pragma unroll
            for (int m = 0; m < 4; ++m) {
                const int row = roff + u.pm * 256 + ai * 128 + wr * 64 + m * 16 + fr;
                if (row < MV) {
                    const float* base = base_in ? (row < MP ? xp + (size_t)row * D : xs + (size_t)(row - MP) * D) : X + (size_t)row * D;
                    const float* gt = mods + (size_t)modidx(row) * NMOD + gi * D;
                    float* xo = X + (size_t)row * D;
#pragma unroll
                    for (int bj = 0; bj < 2; ++bj)
#pragma unroll
                        for (int n = 0; n < 2; ++n) {
                            const int c = c0 + bj * 128 + n * 4;
                            const f32x4 b4 = *(const f32x4*)(base + c), g4 = *(const f32x4*)(gt + c);
                            st_wt((f32x4*)(xo + c), b4 + (g4 * scale) * acc[ai][bj][m][n]);
                        }
                }
            }
    }
};
struct EpiIn {
    static constexpr bool PERM = true, AFTER_DRAIN = false;
    KP kp; int roff;
    __device__ __forceinline__ void operator()(const f32x4 (&acc)[2][2][4][2], const pg8::Unit& u, int wr, int wc, int fr, int fq) const {
        const int pn = u.pn;
        unsigned char* ws = kp->ws; float* out = kp->out;
        bf16_t* Q = (bf16_t*)(ws + WS_Q); bf16_t* KB = (bf16_t*)(ws + WS_KB); bf16_t* VB = (bf16_t*)(ws + WS_VB); bf16_t* U = (bf16_t*)(ws + WS_U); bf16_t* GV = (bf16_t*)(ws + WS_GV); float* SSQ = (float*)(ws + WS_SSQ);
        if (pn < 8) {
            const float* qg = kp->in[I_QG]; const float* kg = kp->in[I_KG];
            const bool isq = pn < 4;
            const float* gvec = isq ? qg : kg; const float osc = isq ? LOG2E * 0.125f : 1.f;
            f32x4 gg[2][2];
#pragma unroll
            for (int bj = 0; bj < 2; ++bj)
#pragma unroll
                for (int n = 0; n < 2; ++n) gg[bj][n] = *(const f32x4*)(gvec + 32 * bj + 8 * fq + 4 * n) * osc;
            const int cb = (pn & 3) * 256 + 64 * wc + 8 * fq;
#pragma unroll
            for (int ai = 0; ai < 2; ++ai)
#pragma unroll
                for (int m = 0; m < 4; ++m) {
                    const int row = roff + u.pm * 256 + ai * 128 + wr * 64 + m * 16 + fr;
                    float ss = 0.f;
#pragma unroll
                    for (int bj = 0; bj < 2; ++bj)
#pragma unroll
                        for (int n = 0; n < 2; ++n) { const f32x4 x = acc[ai][bj][m][n]; ss += (x[0] * x[0] + x[1] * x[1]) + (x[2] * x[2] + x[3] * x[3]); }
                    ss += __shfl_xor(ss, 16); ss += __shfl_xor(ss, 32);
                    const float rstd = rsqrtf(ss * (1.f / 64.f) + EPS);
#pragma unroll
                    for (int bj = 0; bj < 2; ++bj) {
                        const f32x4 o0 = acc[ai][bj][m][0] * rstd * gg[bj][0], o1 = acc[ai][bj][m][1] * rstd * gg[bj][1];
                        const int c = cb + 32 * bj;
                        if (isq) { st_wt((u32x4*)(Q + (size_t)row * D + c), pack8(o0, o1)); }
                        else {
                            st_wt((u32x4*)(KB + (size_t)row * D + c), pack8(o0, o1));
                            if (row < MV) { float* kd = out + (row < MP ? O_KP + (size_t)row * D : O_KS + (size_t)(row - MP) * D) + c; st_wt((f32x4*)kd, o0); st_wt((f32x4*)(kd + 4), o1); }
                        }
                    }
                }
        } else {
            const int sec = (pn - 8) >> 2;
            const int cb = ((pn - 8) & 3) * 256 + 32 * wc + 8 * fq;
#pragma unroll
            for (int ai = 0; ai < 2; ++ai)
#pragma unroll
                for (int m = 0; m < 4; ++m) {
                    const int row = roff + u.pm * 256 + ai * 128 + wr * 64 + m * 16 + fr;
                    float ss = 0.f;
#pragma unroll
                    for (int bj = 0; bj < 2; ++bj) {
                        f32x4 o0 = acc[ai][bj][m][0], o1 = acc[ai][bj][m][1];
                        const int c = cb + 128 * bj;
                        if (sec == 0) {
                            st_wt((u32x4*)(VB + (size_t)row * D + c), pack8(o0, o1));
                            if (row < MV) { float* vd = out + (row < MP ? O_VP + (size_t)row * D : O_VS + (size_t)(row - MP) * D) + c; st_wt((f32x4*)vd, o0); st_wt((f32x4*)(vd + 4), o1); }
                        } else {
                            o0 = gelu4(o0); o1 = gelu4(o1);
                            if (sec == 1) { st_wt((u32x4*)(U + (size_t)row * D + c), pack8(o0, o1)); }
                            else {
                                st_wt((u32x4*)(GV + (size_t)row * D + c), pack8(o0, o1));
                                ss += (o0[0] * o0[0] + o0[1] * o0[1]) + (o0[2] * o0[2] + o0[3] * o0[3]) + (o1[0] * o1[0] + o1[1] * o1[1]) + (o1[2] * o1[2] + o1[3] * o1[3]);
                            }
                        }
                    }
                    if (sec == 2) { ss += __shfl_xor(ss, 16); ss += __shfl_xor(ss, 32); if (fq == 0) st_wt(SSQ + (size_t)((pn - 16) * 4 + wc) * MT + row, ss);     }
                }
        }
    }
};
struct EpiGates {
    static constexpr bool PERM = true, AFTER_DRAIN = false;
    KP kp; int roff;
    __device__ __forceinline__ void operator()(const f32x4 (&acc)[2][2][4][2], const pg8::Unit& u, int wr, int wc, int fr, int fq) const {
        const int c0 = u.pn * 256 + wc * 32 + fq * 8;
        bf16_t* G = (bf16_t*)(kp->ws + WS_GATES); const float* bias = kp->in[I_BGATE];
        f32x4 bv[2][2];
#pragma unroll
        for (int bj = 0; bj < 2; ++bj)
#pragma unroll
            for (int n = 0; n < 2; ++n) bv[bj][n] = *(const f32x4*)(bias + c0 + bj * 128 + n * 4);
#pragma unroll
        for (int ai = 0; ai < 2; ++ai)
#pragma unroll
            for (int m = 0; m < 4; ++m) {
                const int row = roff + u.pm * 256 + ai * 128 + wr * 64 + m * 16 + fr;
#pragma unroll
                for (int bj = 0; bj < 2; ++bj) {
                    f32x4 o0 = acc[ai][bj][m][0] + bv[bj][0], o1 = acc[ai][bj][m][1] + bv[bj][1];
#pragma unroll
                    for (int i = 0; i < 4; ++i) { o0[i] = sigmoidf_(o0[i]); o1[i] = sigmoidf_(o1[i]); }
                    st_wt((u32x4*)(G + (size_t)row * 2048 + c0 + bj * 128), pack8(o0, o1));
                }
            }
    }
};
struct EpiBr {
    static constexpr bool PERM = true, AFTER_DRAIN = false;
    KP kp; int goff; int accum; int roff;
    __device__ __forceinline__ void operator()(const f32x4 (&acc)[2][2][4][2], const pg8::Unit& u, int wr, int wc, int fr, int fq) const {
        const int c0 = u.pn * 256 + wc * 32 + fq * 8;
        const bf16_t* G = (const bf16_t*)(kp->ws + WS_GATES); bf16_t* MX = (bf16_t*)(kp->ws + WS_MIXED);
#pragma unroll
        for (int ai = 0; ai < 2; ++ai)
#pragma unroll
            for (int m = 0; m < 4; ++m) {
                const int row = roff + u.pm * 256 + ai * 128 + wr * 64 + m * 16 + fr;
#pragma unroll
                for (int bj = 0; bj < 2; ++bj) {
                    const int c = c0 + bj * 128;
                    const u32x4 g = *(const u32x4*)(G + (size_t)row * 2048 + goff + c);
                    f32x4 o0 = acc[ai][bj][m][0], o1 = acc[ai][bj][m][1];
                    o0 = o0 * (f32x4){bf_lo(g.x), bf_hi(g.x), bf_lo(g.y), bf_hi(g.y)};
                    o1 = o1 * (f32x4){bf_lo(g.z), bf_hi(g.z), bf_lo(g.w), bf_hi(g.w)};
                    bf16_t* mp = MX + (size_t)row * D + c;
                    if (accum) {
                        const u32x4 pv = *(const u32x4*)mp;
                        o0 = o0 + (f32x4){bf_lo(pv.x), bf_hi(pv.x), bf_lo(pv.y), bf_hi(pv.y)};
                        o1 = o1 + (f32x4){bf_lo(pv.z), bf_hi(pv.z), bf_lo(pv.w), bf_hi(pv.w)};
                    }
                    st_wt((u32x4*)mp, pack8(o0, o1));
                }
            }
    }
};

__device__ __forceinline__ void transpose_item(const float* W, int N, int K, int col0, bf16_t* WT, int prow0, int k0, LAS float* scr, int lane) {
#pragma unroll 8
    for (int i = 0; i < 32; ++i) { const int kk = 2 * i + (lane >> 5); scr[kk * 33 + (lane & 31)] = W[(size_t)(k0 + kk) * N + col0 + (lane & 31)]; }
    LDS_WAIT();
    const int c = lane & 7;
#pragma unroll
    for (int j = 0; j < 4; ++j) {
        const int n = (lane >> 3) + 8 * j; const LAS float* s = scr + (8 * c) * 33 + n;
        u32x4 o; o.x = cvt_pk(s[0 * 33], s[1 * 33]); o.y = cvt_pk(s[2 * 33], s[3 * 33]); o.z = cvt_pk(s[4 * 33], s[5 * 33]); o.w = cvt_pk(s[6 * 33], s[7 * 33]);
        st_wt((u32x4*)(WT + (size_t)(prow0 + n) * K + k0 + 8 * c), o);
    }
    LDS_WAIT();
}
__device__ __forceinline__ void transpose_mat(const float* W, int N, int K, int npos, int kind, bf16_t* WT, int item, LAS float* scr, int lane) {
    const int nblk = npos / 32, kb = item / nblk, pb = item % nblk, p0 = pb * 32;
    int col0 = p0;
    if (kind == 1) { const int pn = p0 >> 8, r = p0 & 255; col0 = (r >> 7) * DFF + 128 * pn + (r & 127); }
    else if (kind == 2 && p0 < 2048) { const int pn = p0 >> 8, r = p0 & 255, bj = r >> 7, wc = (r & 127) >> 5; col0 = 256 * pn + 64 * wc + 32 * bj; }
    transpose_item(W, N, K, col0, WT, p0, kb * 64, scr, lane);
}

__device__ __forceinline__ void prologue(KP p, LAS unsigned char* lds, int vcu, int G) {
    const int tid = tid_opaque(), lane = tid & 63, wid = __builtin_amdgcn_readfirstlane(tid >> 6);
    unsigned char* ws = p->ws;
    float* mods = (float*)(ws + WS_MODS);
    if (vcu < NMOD / 64) {
        LAS float* sc = (LAS float*)lds;
        LAS float* red = (LAS float*)(lds + 65536);
        for (int i = tid; i < 16 * D; i += 512) { const int r = i >> 10, k = i & 1023; const float c = r < 8 ? p->in[I_CP][r * D + k] : p->in[I_CS][(r - 8) * D + k]; sc[i] = siluf_(c); }
        __syncthreads();
        const int n0 = vcu * 64;
        float acc[16];
#pragma unroll
        for (int r = 0; r < 16; ++r) acc[r] = 0.f;
        const float* w = p->in[I_ADAW] + (size_t)(128 * wid) * NMOD + n0 + lane;
        for (int k4 = 0; k4 < 32; ++k4) {
            float wv[4];
#pragma unroll
            for (int i = 0; i < 4; ++i) wv[i] = w[(size_t)(k4 * 4 + i) * NMOD];
#pragma unroll
            for (int r = 0; r < 16; ++r) { const f32x4 s4 = *(const LAS f32x4*)(sc + r * D + 128 * wid + 4 * k4); acc[r] += (s4[0] * wv[0] + s4[1] * wv[1]) + (s4[2] * wv[2] + s4[3] * wv[3]); }
        }
#pragma unroll
        for (int r = 0; r < 16; ++r) red[(wid * 16 + r) * 64 + lane] = acc[r];
        __syncthreads();
        for (int o = tid; o < 1024; o += 512) {
            const int r = o >> 6, c = o & 63; float s = 0.f;
#pragma unroll
            for (int w8 = 0; w8 < 8; ++w8) s += red[(w8 * 16 + r) * 64 + c];
            st_wt(mods + (size_t)r * NMOD + n0 + c, s + p->in[I_ADAB][n0 + c]);
        }
        __syncthreads();
    }
    {
        const int e = vcu * 512 + tid;
        if (e < 8 * 4 * 8 * 64) {
            const int ln = e & 63, ks = (e >> 6) & 7, mt = (e >> 9) & 3, gg = e >> 11, r32_ = ln & 31, hi_ = ln >> 5;
            const int t = 32 * mt + r32_, s0 = 16 * ks + 4 * hi_;
            const float* wp = p->in[I_GWS] + (size_t)gg * 16384 + t * 128 + s0;
            f32x4 a0 = *(const f32x4*)wp, a1 = *(const f32x4*)(wp + 8);
#pragma unroll
            for (int i = 0; i < 4; ++i) { if (s0 + i > t) a0[i] = 0.f; if (s0 + 8 + i > t) a1[i] = 0.f; }
            st_wt((u32x4*)(ws + WS_WF) + e, pack8(a0, a1));
        }
    }
    LAS float* scr = (LAS float*)(lds + wid * 16384);
    const int gw = vcu * 8 + wid, NGW = G * 8;
    constexpr int I_UP = 16 * 176, I_DN = 44 * 32, I_IN = 16 * 160, I_GT = 16 * 64, I_SQ = 16 * 32;
    constexpr int NITEMS = 2 * I_UP + 2 * I_DN + I_IN + I_GT + 3 * I_SQ;
    for (int it = gw; it < NITEMS; it += NGW) {
        int r = it;
        if (r < I_UP) { transpose_mat(p->in[I_WGU1], 2 * DFF, D, 2 * DFF, 1, (bf16_t*)(ws + WS_WGU1), r, scr, lane); continue; } r -= I_UP;
        if (r < I_UP) { transpose_mat(p->in[I_WGU2], 2 * DFF, D, 2 * DFF, 1, (bf16_t*)(ws + WS_WGU2), r, scr, lane); continue; } r -= I_UP;
        if (r < I_DN) { transpose_mat(p->in[I_WD1], D, DFF, D, 0, (bf16_t*)(ws + WS_WD1), r, scr, lane); continue; } r -= I_DN;
        if (r < I_DN) { transpose_mat(p->in[I_WD2], D, DFF, D, 0, (bf16_t*)(ws + WS_WD2), r, scr, lane); continue; } r -= I_DN;
        if (r < I_IN) { transpose_mat(p->in[I_WIN], 5120, D, 5120, 2, (bf16_t*)(ws + WS_WIN), r, scr, lane); continue; } r -= I_IN;
        if (r < I_GT) { transpose_mat(p->in[I_WGATE], 2048, D, 2048, 0, (bf16_t*)(ws + WS_WGT), r, scr, lane); continue; } r -= I_GT;
        if (r < I_SQ) { transpose_mat(p->in[I_WBR], D, D, D, 0, (bf16_t*)(ws + WS_WBA), r, scr, lane); continue; } r -= I_SQ;
        if (r < I_SQ) { transpose_mat(p->in[I_WBR] + (size_t)D * D, D, D, D, 0, (bf16_t*)(ws + WS_WBB), r, scr, lane); continue; } r -= I_SQ;
        transpose_mat(p->in[I_WOUT], D, D, D, 0, (bf16_t*)(ws + WS_WOUT), r, scr, lane);
    }
}

__device__ __forceinline__ void norm_rows(KP p, int mode, int vcu, int G) {
    const int tid = tid_opaque(), lane = tid & 63, wid = tid >> 6;
    const int gw = vcu * 8 + wid, NGW = G * 8;
    float* X = p->out + O_Y; bf16_t* HN = (bf16_t*)(p->ws + (mode == 1 ? WS_HN2 : WS_HN)); const float* mods = (const float*)(p->ws + WS_MODS);
    const float* g = p->in[I_NORMG] + mode * D;
    f32x4 g4[4];
#pragma unroll
    for (int j = 0; j < 4; ++j) g4[j] = ((const f32x4*)g)[64 * j + lane];
    for (int row = gw; row < MV; row += NGW) {
        const float* src = mode == 0 ? (row < MP ? p->in[I_XP] + (size_t)row * D : p->in[I_XS] + (size_t)(row - MP) * D) : X + (size_t)row * D;
        f32x4 v[4]; float s = 0.f;
#pragma unroll
        for (int j = 0; j < 4; ++j) { v[j] = ((const f32x4*)src)[64 * j + lane]; s += (v[j][0] * v[j][0] + v[j][1] * v[j][1]) + (v[j][2] * v[j][2] + v[j][3] * v[j][3]); }
        const float rstd = rsqrtf(wave_sum(s) * (1.f / D) + EPS);
        if (mode < 3) {
            const float* sh = mods + (size_t)modidx(row) * NMOD + (3 * mode) * D; const float* sc = sh + D;
            u32x2* o8 = (u32x2*)(HN + (size_t)row * D);
#pragma unroll
            for (int j = 0; j < 4; ++j) {
                const f32x4 s4 = ((const f32x4*)sc)[64 * j + lane], h4 = ((const f32x4*)sh)[64 * j + lane];
                const f32x4 o = (v[j] * rstd) * g4[j] * (s4 + 1.f) + h4;
                u32x2 w; w.x = cvt_pk(o[0], o[1]); w.y = cvt_pk(o[2], o[3]); st_wt(o8 + 64 * j + lane, w);
            }
        } else {
#ifdef PROBE_YS
            const float pfac = row < MP ? PROBE_YS : 1.f;
#else
            const float pfac = 1.f;
#endif
#pragma unroll
            for (int j = 0; j < 4; ++j) ((f32x4*)(X + (size_t)row * D))[64 * j + lane] = (v[j] * (rstd * pfac)) * g4[j];
        }
    }
}

#ifndef PROBE_EXPLICIT_BIAS
#define PROBE_EXPLICIT_BIAS 0
#endif
__device__ __forceinline__ void glds16(const void* gsrc, unsigned lds_dst) {
    unsigned keep; const unsigned dst = (unsigned)__builtin_amdgcn_readfirstlane((int)lds_dst);
    asm volatile("s_mov_b32 %0, m0\n\ts_mov_b32 m0, %2\n\ts_nop 0\n\tglobal_load_lds_dwordx4 %1, off\n\ts_mov_b32 m0, %0" : "=&s"(keep) : "v"(gsrc), "s"(dst) : "memory");
}
__device__ __forceinline__ v4i16_t vtr(const LAS unsigned char* p) { return __builtin_amdgcn_ds_read_tr16_b64_v4i16((LAS v4i16_t*)p); }
__device__ __forceinline__ void attn_unit(const bf16_t* Q, const bf16_t* Kb, const bf16_t* Vb, bf16_t* O, const float* subg,
                                          int b, int h, int j, LAS unsigned char* lds, float lam, float M2, float win) {
    const int tid = tid_opaque(), lane = tid & 63, r32 = lane & 31, hi = lane >> 5;
    const int wid = __builtin_amdgcn_readfirstlane(tid >> 6);
    const int m = wid & 1, rg = wid >> 1;
    const int q0 = 128 * j + 32 * rg, myc = 2 * j + (rg >> 1), ntiles = 2 * j + 2;
    int kt0 = (int)floorf((128.f * (float)j - 63.f - win) * (1.f / 64.f)) + 1; kt0 = kt0 < 0 ? 0 : kt0;
    const size_t rowbase = (size_t)b * TSEQ;
    const float slope2 = ldexpf(LOG2E, -(h + 1));
    const bf16_t* ksrc = Kb + (rowbase + (tid & 63)) * D + h * 128 + (tid >> 6) * 8;
    const bf16_t* vsrc = Vb + (rowbase + 16 * (wid & 3) + (lane >> 2)) * D + h * 128 + 32 * (wid >> 2) + 8 * (lane & 3);
    bf16x8 qr[4];
    { const bf16_t* qw = Q + (rowbase + q0 + r32) * D + h * 128 + m * 64 + 8 * hi;
#pragma unroll
      for (int d0 = 0; d0 < 4; ++d0) qr[d0] = *(const bf16x8*)(qw + 16 * d0); }
    asm volatile("" : "+v"(qr[0]), "+v"(qr[1]), "+v"(qr[2]), "+v"(qr[3]));
    const float pa = -slope2 * (float)(r32 - 4 * hi);
    f32x16 o[4];
#pragma unroll
    for (int d0 = 0; d0 < 4; ++d0)
#pragma unroll
        for (int r = 0; r < 16; ++r) o[d0][r] = 0.f;
    float lsum = 0.f;
    const int koff = (m * 8 + hi) * 1024 + r32 * 16;
    const int voff = 16384 + ((lane >> 4) & 1) * 32 + (lane & 3) * 8 + (4 * hi + ((lane & 15) >> 2)) * 64;
    const unsigned lbase = (unsigned)(uintptr_t)lds + (unsigned)wid * 1024u;
#define ATT_STAGE(kt_, s_) do { const size_t go_ = (size_t)(kt_) * 64 * D; const unsigned lb_ = lbase + (unsigned)(s_) * 32768u; \
        glds16(ksrc + go_, lb_); glds16(ksrc + go_ + 64, lb_ + 8192u); glds16(vsrc + go_, lb_ + 16384u); glds16(vsrc + go_ + 64, lb_ + 24576u); } while (0)
    ATT_STAGE(kt0, kt0 & 3); ATT_STAGE(kt0 + 1, (kt0 + 1) & 3);
    if (kt0 + 2 < ntiles) { ATT_STAGE(kt0 + 2, (kt0 + 2) & 3); asm volatile("s_waitcnt vmcnt(8)" ::: "memory"); }
    else asm volatile("s_waitcnt vmcnt(4)" ::: "memory");
    __syncthreads();
    for (int kt = kt0; kt < ntiles; ++kt) {
        const LAS unsigned char* buf = lds + (kt & 3) * 32768;
        const bool more = kt + 3 < ntiles;
        if (more) ATT_STAGE(kt + 3, (kt + 3) & 3);
        if (kt <= myc) {
            f32x16 p0, p1;
            if (kt < myc && !PROBE_EXPLICIT_BIAS) {
                const float c0 = pa - slope2 * (float)(q0 - 64 * kt) - M2, c1 = c0 + 32.f * slope2;
#pragma unroll
                for (int r = 0; r < 16; ++r) { const float kr = (float)((r & 3) + 8 * (r >> 2)); p0[r] = fmaf(slope2, kr, c0); p1[r] = fmaf(slope2, kr, c1); }
            } else {
#pragma unroll
                for (int r = 0; r < 16; ++r) { const float dq = (float)(q0 + r32 - 64 * kt - crow(r, hi)); p0[r] = -slope2 * fabsf(dq) - M2; p1[r] = -slope2 * fabsf(dq - 32.f) - M2; }
            }
            const LAS unsigned char* kb = buf + koff;
            bf16x8 kf[8];
#pragma unroll
            for (int d0 = 0; d0 < 4; ++d0) { kf[2 * d0] = *(const LAS bf16x8*)(kb + d0 * 2048); kf[2 * d0 + 1] = *(const LAS bf16x8*)(kb + d0 * 2048 + 512); }
            __builtin_amdgcn_sched_barrier(0);
#pragma unroll
            for (int d0 = 0; d0 < 4; ++d0) {
                p0 = __builtin_amdgcn_mfma_f32_32x32x16_bf16(kf[2 * d0], qr[d0], p0, 0, 0, 0);
                p1 = __builtin_amdgcn_mfma_f32_32x32x16_bf16(kf[2 * d0 + 1], qr[d0], p1, 0, 0, 0);
            }
            float sa = 0.f, sb = 0.f;
#pragma unroll
            for (int r = 0; r < 16; ++r) { p0[r] = __builtin_amdgcn_exp2f(p0[r]); p1[r] = __builtin_amdgcn_exp2f(p1[r]); sa += p0[r]; sb += p1[r]; }
            lsum += sa + sb;
            u32x4 pw[4];
            pw[0] = (u32x4){cvt_pk(p0[0], p0[1]), cvt_pk(p0[2], p0[3]), cvt_pk(p0[4], p0[5]), cvt_pk(p0[6], p0[7])};
            pw[1] = (u32x4){cvt_pk(p0[8], p0[9]), cvt_pk(p0[10], p0[11]), cvt_pk(p0[12], p0[13]), cvt_pk(p0[14], p0[15])};
            pw[2] = (u32x4){cvt_pk(p1[0], p1[1]), cvt_pk(p1[2], p1[3]), cvt_pk(p1[4], p1[5]), cvt_pk(p1[6], p1[7])};
            pw[3] = (u32x4){cvt_pk(p1[8], p1[9]), cvt_pk(p1[10], p1[11]), cvt_pk(p1[12], p1[13]), cvt_pk(p1[14], p1[15])};
            const LAS unsigned char* vb = buf + voff;
#pragma unroll
            for (int d0 = 0; d0 < 4; ++d0) {
                v4i16_t lo[4], hh[4];
#pragma unroll
                for (int ks = 0; ks < 4; ++ks) { lo[ks] = vtr(vb + d0 * 4096 + ks * 1024); hh[ks] = vtr(vb + d0 * 4096 + ks * 1024 + 512); }
#pragma unroll
                for (int ks = 0; ks < 4; ++ks) {
                    const bf16x8 vf = (bf16x8){lo[ks][0], lo[ks][1], lo[ks][2], lo[ks][3], hh[ks][0], hh[ks][1], hh[ks][2], hh[ks][3]};
                    o[d0] = __builtin_amdgcn_mfma_f32_32x32x16_bf16(__builtin_bit_cast(bf16x8, pw[ks]), vf, o[d0], 0, 0, 0);
                }
            }
        }
        if (more) asm volatile("s_waitcnt vmcnt(8)" ::: "memory");
        else asm volatile("s_waitcnt vmcnt(0)" ::: "memory");
        __syncthreads();
    }
    lsum += __shfl_xor(lsum, 32);
    LAS float* wsf = (LAS float*)(lds + 131072) + wid * 32;
    if (hi == 0) wsf[r32] = lsum;
    LDS_WAIT();
    float f[16];
    const float fs = m == 0 ? 1.f : -lam;
#pragma unroll
    for (int r = 0; r < 16; ++r) f[r] = fs / wsf[crow(r, hi)];
    LAS float* CB = (LAS float*)lds;
    if (m == 1) {
#pragma unroll
        for (int d0 = 0; d0 < 4; ++d0)
#pragma unroll
            for (int r = 0; r < 16; ++r) CB[(32 * rg + crow(r, hi)) * 132 + 32 * d0 + r32] = o[d0][r] * f[r];
    }
    __syncthreads();
    if (m == 0) {
#pragma unroll
        for (int d0 = 0; d0 < 4; ++d0)
#pragma unroll
            for (int r = 0; r < 16; ++r) CB[(32 * rg + crow(r, hi)) * 132 + 32 * d0 + r32] += o[d0][r] * f[r];
    }
    __syncthreads();
    {
        const int row = tid >> 2, part = tid & 3;
        f32x4 v[8]; float ss = 0.f;
#pragma unroll
        for (int i = 0; i < 8; ++i) { v[i] = *(const LAS f32x4*)(CB + row * 132 + 32 * part + 4 * i); ss += (v[i][0] * v[i][0] + v[i][1] * v[i][1]) + (v[i][2] * v[i][2] + v[i][3] * v[i][3]); }
        ss += __shfl_xor(ss, 1); ss += __shfl_xor(ss, 2);
        const float rstd = rsqrtf(ss * (1.f / 128.f) + EPS) * 0.8f;
        bf16_t* op = O + (rowbase + 128 * j + row) * D + h * 128 + 32 * part;
#pragma unroll
        for (int i = 0; i < 4; ++i) {
            const f32x4 ga = *(const f32x4*)(subg + 32 * part + 8 * i), gb = *(const f32x4*)(subg + 32 * part + 8 * i + 4);
            st_wt((u32x4*)(op + 8 * i), pack8(v[2 * i] * rstd * ga, v[2 * i + 1] * rstd * gb));
        }
    }
    __syncthreads();
#undef ATT_STAGE
}

__device__ __forceinline__ void spatial_unit(const bf16_t* GV, bf16_t* US, const float* SSQ, const float* vg, const float* Ws, const float* bs, int ci, LAS unsigned char* lds, const unsigned char* WFp, unsigned char* DBGP = nullptr, bf16_t* USo = nullptr) {
    const int tid = tid_opaque(), lane = tid & 63, r32 = lane & 31, hi = lane >> 5;
    const int g = __builtin_amdgcn_readfirstlane(tid >> 6);
    LAS unsigned char* wbuf = lds + g * 16384;
    LAS float* rst = (LAS float*)(lds + 131072) + g * 128;
    const int R0 = 128 * ci;
#pragma unroll
    for (int i = 0; i < 2; ++i) {
        const int rr = lane + 64 * i; float s = 0.f;
#pragma unroll
        for (int sl = 0; sl < 16; ++sl) s += SSQ[(size_t)sl * MT + R0 + rr];
        rst[rr] = rsqrtf(s * (1.f / 1024.f) + EPS);
    }
    LDS_WAIT();
    const int laneoff = ((lane >> 4) & 1) * 32 + (lane & 3) * 8 + (4 * hi + ((lane & 15) >> 2)) * 64;
    const float* Wg = Ws + (size_t)g * 16384; (void)Wg;
    const u32x4* Wf = (const u32x4*)WFp;
    for (int hh = 0; hh < 2; ++hh) {
#pragma unroll 4
        for (int pc = 0; pc < 16; ++pc) {
            const int d0 = pc >> 3, ks = pc & 7, row = 16 * ks + (lane >> 2), col = g * 128 + 64 * hh + 32 * d0 + 8 * (lane & 3);
            const u32x4 raw = *(const u32x4*)(GV + (size_t)(R0 + row) * D + col);
            const float rs = rst[row];
            const f32x4 ga = *(const f32x4*)(vg + col) * rs, gb = *(const f32x4*)(vg + col + 4) * rs;
            const f32x4 a = (f32x4){bf_lo(raw.x), bf_hi(raw.x), bf_lo(raw.y), bf_hi(raw.y)} * ga, b4 = (f32x4){bf_lo(raw.z), bf_hi(raw.z), bf_lo(raw.w), bf_hi(raw.w)} * gb;
            *(LAS u32x4*)(wbuf + pc * 1024 + lane * 16) = pack8(a, b4);
        }
        LDS_WAIT();
#pragma unroll 1
        for (int mt = 0; mt < 4; ++mt) {
            f32x16 o[2];
#pragma unroll
            for (int nt = 0; nt < 2; ++nt)
#pragma unroll
                for (int r = 0; r < 16; ++r) o[nt][r] = 0.f;
#pragma unroll 4
            for (int ks = 0; ks < 2 * mt + 2; ++ks) {
                bf16x8 vf[2];
#pragma unroll
                for (int nt = 0; nt < 2; ++nt) {
                    const v4i16_t lo = vtr(wbuf + nt * 8192 + ks * 1024 + laneoff), hh2 = vtr(wbuf + nt * 8192 + ks * 1024 + 512 + laneoff);
                    vf[nt] = (bf16x8){lo[0], lo[1], lo[2], lo[3], hh2[0], hh2[1], hh2[2], hh2[3]};
                }
                const bf16x8 af = __builtin_bit_cast(bf16x8, Wf[((g * 4 + mt) * 8 + ks) * 64 + lane]);
#pragma unroll
                for (int nt = 0; nt < 2; ++nt) o[nt] = __builtin_amdgcn_mfma_f32_32x32x16_bf16(af, vf[nt], o[nt], 0, 0, 0);
            }
#ifdef SELFCHK2
            {
                const int tt = 32 * mt + crow(5, hi), col = g * 128 + 64 * hh + 32 + r32;
                float mixn = bs[g * 128 + tt];
                for (int s = 0; s <= tt; ++s) mixn += Wg[tt * 128 + s] * (bf2f(GV[(size_t)(R0 + s) * D + col]) * rst[s] * vg[col]);
                const float mf = o[1][5] + bs[g * 128 + tt];
                const float rel = fabsf(mf - mixn) / (fabsf(mixn) + 0.1f);
                if (rel > 0.05f) atomicAdd((unsigned*)DBGP + 1, 1u);
                atomicAdd((unsigned*)DBGP + 2, 1u);
            }
#endif
#pragma unroll
            for (int r = 0; r < 16; ++r) {
                const int tt = 32 * mt + crow(r, hi); const float bb = bs[g * 128 + tt];
#pragma unroll
                for (int nt = 0; nt < 2; ++nt) {
                    bf16_t* up = US + (size_t)(R0 + tt) * D + g * 128 + 64 * hh + 32 * nt + r32;
                    bf16_t* uo = (USo ? USo : US) + (size_t)(R0 + tt) * D + g * 128 + 64 * hh + 32 * nt + r32;
#ifdef PROBE_NOWV
                    st_wt(uo, f2bf(bf2f(*up) * (0.f * o[nt][r] + bb)));
#else
                    st_wt(uo, f2bf(bf2f(*up) * (o[nt][r] + bb)));
#endif
                }
            }
        }
        LDS_WAIT();
    }
}

__device__ __forceinline__ void sample_spatial_unit(const bf16_t* GV, bf16_t* US, const float* SSQ, const float* vg, const float* Ws, const float* bs, float* gs_out, int b, LAS unsigned char* lds) {
    const int tid = tid_opaque();
    LAS float* rst = (LAS float*)lds;
    if (tid < 16) { float s = 0.f; for (int i = 0; i < 16; ++i) s += SSQ[(size_t)i * MT + MP + 16 * b + tid]; rst[tid] = rsqrtf(s * (1.f / 1024.f) + EPS); }
    __syncthreads();
    for (int c = tid; c < D; c += 512) {
        const int g = c >> 7; const float gc = vg[c];
        float gvn[16];
#pragma unroll
        for (int s = 0; s < 16; ++s) { gvn[s] = bf2f(GV[(size_t)(MP + 16 * b + s) * D + c]) * rst[s] * gc; gs_out[(size_t)(16 * b + s) * D + c] = gvn[s]; }
#pragma unroll
        for (int t = 0; t < 16; ++t) {
            float mix = bs[g * 128 + t];
#pragma unroll
            for (int s = 0; s < 16; ++s) if (s <= t) mix += Ws[(size_t)g * 16384 + t * 128 + s] * gvn[s];
            bf16_t* up = US + (size_t)(MP + 16 * b + t) * D + c;
            st_wt(up, f2bf(bf2f(*up) * mix));
        }
    }
    __syncthreads();
}

__device__ __forceinline__ void sample_attn_unit(KP p, const bf16_t* Q, bf16_t* O, int b, int h, int qg4, float lam, LAS unsigned char* lds) {
    const int tid = tid_opaque(), lane = tid & 63, wid = tid >> 6;
    constexpr int NK = 1040;
    LAS float* qs = (LAS float*)lds;
    LAS float* scb = (LAS float*)(lds + 8192);
    LAS float* lrow = (LAS float*)(lds + 8192 + 4 * NK * 4);
    LAS float* red = lrow + 4;
    LAS float* part = (LAS float*)(lds + 32768);
    const float* KS = p->out + O_KS; const float* VS = p->out + O_VS;
    const float slope2 = ldexpf(LOG2E, -(h + 1));
    const int qrow0 = 16 * b + 4 * qg4;
    { const int mm = tid >> 8, q = (tid >> 6) & 3, dd = tid & 63; qs[tid] = bf2f(Q[(size_t)(MP + qrow0 + q) * D + h * 128 + mm * 64 + dd]); }
    __syncthreads();
    const int qi = tid >> 7, d = tid & 127;
    float res = 0.f;
    for (int m = 0; m < 2; ++m) {
        for (int kk = tid; kk < NK; kk += 512) {
            const float* kp = kk < 1024 ? p->in[I_CK] + (((size_t)b * 1024 + kk) * 8 + h) * 128 + m * 64 : KS + (size_t)(16 * b + kk - 1024) * D + h * 128 + m * 64;
            f32x4 kv[16];
#pragma unroll
            for (int i = 0; i < 16; ++i) kv[i] = ((const f32x4*)kp)[i];
#pragma unroll
            for (int q = 0; q < 4; ++q) {
                const LAS f32x4* qp = (const LAS f32x4*)(qs + (m * 4 + q) * 64);
                float dot = 0.f;
#pragma unroll
                for (int i = 0; i < 16; ++i) { const f32x4 q4 = qp[i]; dot += (q4[0] * kv[i][0] + q4[1] * kv[i][1]) + (q4[2] * kv[i][2] + q4[3] * kv[i][3]); }
                scb[q * NK + kk] = dot - slope2 * fabsf((float)(1024 + 4 * qg4 + q - kk));
            }
        }
        __syncthreads();
        if (wid < 4) {
            float mx = -3.0e38f;
            for (int kk = lane; kk < NK; kk += 64) mx = fmaxf(mx, scb[wid * NK + kk]);
            mx = wave_max(mx);
            float sum = 0.f;
            for (int kk = lane; kk < NK; kk += 64) { const float e = __builtin_amdgcn_exp2f(scb[wid * NK + kk] - mx); scb[wid * NK + kk] = e; sum += e; }
            sum = wave_sum(sum);
            if (lane == 0) lrow[wid] = sum;
        }
        __syncthreads();
        {
            const int ksl = tid >> 7, k0 = ksl * 260, k1 = k0 + 260;
            float a4[4] = {0.f, 0.f, 0.f, 0.f};
            const float* cv = p->in[I_CV] + ((size_t)b * 1024 * 8 + h) * 128 + d;
#pragma unroll 8
            for (int kk = k0; kk < k1; ++kk) {
                const float v = kk < 1024 ? cv[(size_t)kk * 1024] : VS[(size_t)(16 * b + kk - 1024) * D + h * 128 + d];
#pragma unroll
                for (int q = 0; q < 4; ++q) a4[q] += scb[q * NK + kk] * v;
            }
#pragma unroll
            for (int q = 0; q < 4; ++q) part[(ksl * 4 + q) * 128 + d] = a4[q];
            __syncthreads();
            const float acc = (part[(0 * 4 + qi) * 128 + d] + part[(1 * 4 + qi) * 128 + d]) + (part[(2 * 4 + qi) * 128 + d] + part[(3 * 4 + qi) * 128 + d]);
            res += (m == 0 ? 1.f : -lam) * acc / lrow[qi];
        }
        __syncthreads();
    }
    { const float s = wave_sum(res * res); if (lane == 0) red[wid] = s; }
    __syncthreads();
    const float tot = red[2 * qi] + red[2 * qi + 1];
    const float rstd = rsqrtf(tot * (1.f / 128.f) + EPS);
    st_wt(O + (size_t)(MP + qrow0 + qi) * D + h * 128 + d, f2bf(res * rstd * p->in[I_SUBG][d] * 0.8f));
    __syncthreads();
}

#if defined(SELFCHK) || defined(O_SEPARATE)
constexpr size_t WS_O2 = 840 * MiB;
#endif
#ifdef SELFCHK
constexpr size_t WS_DBG = WS_END + 32768;
__device__ __forceinline__ void check_attn_rows(KP p, int b, int h, int t0, float lam, LAS unsigned char* lds) {
    const int tid = tid_opaque(), lane = tid & 63, wid = tid >> 6;
    const bf16_t* Q = (const bf16_t*)(p->ws + WS_Q); const bf16_t* KB = (const bf16_t*)(p->ws + WS_KB); const bf16_t* VB = (const bf16_t*)(p->ws + WS_VB);
    const bf16_t* O2 = (const bf16_t*)(p->ws + WS_O2);
    LAS float* scb = (LAS float*)lds;
    LAS float* qs = (LAS float*)(lds + 131072);
    LAS float* lrow = qs + 512;
    LAS float* red = lrow + 4;
    const size_t rowbase = (size_t)b * TSEQ;
    const int kend = 64 * (t0 / 64 + 1);
    const float slope2 = ldexpf(LOG2E, -(h + 1));
    { const int mm = tid >> 8, qi = (tid >> 6) & 3, d = tid & 63; qs[tid] = bf2f(Q[(rowbase + t0 + qi) * D + h * 128 + mm * 64 + d]); }
    __syncthreads();
    const int qi = tid >> 7, d = tid & 127;
    float res = 0.f;
    for (int mm = 0; mm < 2; ++mm) {
        for (int kk = tid; kk < kend; kk += 512) {
            const bf16_t* kp = KB + (rowbase + kk) * D + h * 128 + mm * 64;
            float dot[4] = {0.f, 0.f, 0.f, 0.f};
            for (int dd = 0; dd < 64; ++dd) { const float kv = bf2f(kp[dd]);
#pragma unroll
                for (int q = 0; q < 4; ++q) dot[q] += qs[(mm * 4 + q) * 64 + dd] * kv; }
#pragma unroll
            for (int q = 0; q < 4; ++q) scb[q * 8192 + kk] = dot[q] - slope2 * fabsf((float)(t0 + q - kk));
        }
        __syncthreads();
        if (wid < 4) {
            float mx = -3.0e38f;
            for (int kk = lane; kk < kend; kk += 64) mx = fmaxf(mx, scb[wid * 8192 + kk]);
            mx = wave_max(mx);
            float sum = 0.f;
            for (int kk = lane; kk < kend; kk += 64) { const float e = __builtin_amdgcn_exp2f(scb[wid * 8192 + kk] - mx); scb[wid * 8192 + kk] = e; sum += e; }
            sum = wave_sum(sum);
            if (lane == 0) lrow[wid] = sum;
        }
        __syncthreads();
        float acc = 0.f;
        for (int kk = 0; kk < kend; ++kk) acc += scb[qi * 8192 + kk] * bf2f(VB[(rowbase + kk) * D + h * 128 + d]);
        res += (mm == 0 ? 1.f : -lam) * acc / lrow[qi];
        __syncthreads();
    }
    { const float s = wave_sum(res * res); if (lane == 0) red[wid * 2] = s; }
    __syncthreads();
    const float tot = red[(2 * qi) * 2] + red[(2 * qi + 1) * 2];
    const float ref = res * rsqrtf(tot * (1.f / 128.f) + EPS) * p->in[I_SUBG][d] * 0.8f;
    const float fast = bf2f(O2[(rowbase + t0 + qi) * D + h * 128 + d]);
    __syncthreads();
    { const float e2 = wave_sum((fast - ref) * (fast - ref)), r2 = wave_sum(ref * ref); if (lane == 0) { red[wid * 2] = e2; red[wid * 2 + 1] = r2; } }
    __syncthreads();
    if (tid < 4) {
        const float e2 = red[(2 * tid) * 2] + red[(2 * tid + 1) * 2], r2 = red[(2 * tid) * 2 + 1] + red[(2 * tid + 1) * 2 + 1];
        const float rel = sqrtf(e2 / (r2 + 1e-30f));
        atomicMax((unsigned*)(p->ws + WS_DBG), __float_as_uint(rel));
        if (rel > 0.1f) atomicAdd((unsigned*)(p->ws + WS_DBG) + 1, 1u);
        atomicAdd((unsigned*)(p->ws + WS_DBG) + 2, 1u);
    }
    __syncthreads();
}
#endif

#ifdef SELFCHK4
__device__ __forceinline__ float chk_dot(const bf16_t* arow, const float* W, int ldw, int col, int K, int ln) {
    float s = 0.f;
    for (int k = ln; k < K; k += 64) s += bf2f(arow[k]) * W[(size_t)k * ldw + col];
    return wave_sum(s);
}
__device__ __forceinline__ void check_gemms(KP p, int which, int vcu, int G) {
    const int tid = tid_opaque(), ln = tid & 63, wv = tid >> 6;
    unsigned char* ws = p->ws; unsigned* dbg = (unsigned*)(ws + WS_END + 32768);
    const bf16_t* HNp = (const bf16_t*)(ws + (which == 0 ? WS_HN2 : WS_HN)); const bf16_t* GT = (const bf16_t*)(ws + WS_GATES);
    const bf16_t* OB = (const bf16_t*)(ws + WS_Q); const bf16_t* SB = (const bf16_t*)(ws + WS_U); const bf16_t* MX = (const bf16_t*)(ws + WS_MIXED);
    unsigned nb = 0, nt = 0;
    for (int it = 0; it < 32; ++it) {
#ifdef CHK4_ROWWISE
        const unsigned id = (unsigned)(vcu * 8 + wv);
        const unsigned hsh = id * 2654435761u;
        const int row = (int)(hsh >> 8) % CHK4_ROWS + CHK4_ROW0; const int col = (it * 32 + (int)(hsh & 31)) & 1023;
#else
        const unsigned id = (unsigned)((vcu * 8 + wv) * 32 + it);
        const unsigned hsh = id * 2654435761u;
        const int row = (int)(hsh >> 8) % CHK4_ROWS + CHK4_ROW0; const int col = (int)((hsh * 40503u) >> 12) & 1023;
#endif
        if (which == 0) {
#pragma unroll 1
            for (int hf = 0; hf < 2; ++hf) {
                const int c = col + 1024 * hf;
                const float z = chk_dot(HNp + (size_t)row * D, p->in[I_WGATE], 2048, c, D, ln) + p->in[I_BGATE][c];
                const size_t gi_ = (size_t)row * 2048 + c;
                const float ref = 1.f / (1.f + expf(-z)), got = bf2f(GT[gi_]);
                const unsigned wcoh = __hip_atomic_load((const unsigned*)(GT + (gi_ & ~(size_t)1)), __ATOMIC_RELAXED, __HIP_MEMORY_SCOPE_AGENT);
                const float gotc = (gi_ & 1) ? bf_hi(wcoh) : bf_lo(wcoh);
#if defined(CHK4_MODE) && CHK4_MODE == 1
                if (got != gotc) ++nb;
#elif defined(CHK4_MODE) && CHK4_MODE == 5
                if (fabsf(ref - gotc) > 0.02f && row < 32768) {
                    const float kold = bf2f(f2bf(p->out[O_KP + (size_t)(2 * row + hf) * D + col]));
                    if (gotc == kold) ++nb;
                }
#elif defined(CHK4_MODE) && CHK4_MODE == 4
                if (fabsf(ref - gotc) > 0.02f && fabsf(gotc) < 1e-6f) ++nb;
#elif defined(CHK4_MODE) && CHK4_MODE == 3
                if (fabsf(ref - gotc) > 0.02f && (gotc < 0.f || gotc > 1.f)) ++nb;
#elif defined(CHK4_MODE) && CHK4_MODE == 2
                if (fabsf(ref - gotc) > 0.02f) ++nb;
#else
                if (fabsf(ref - got) > 0.02f) ++nb;
#endif
                ++nt;
            }
        } else if (which == 2) {
            const bf16_t* HIDp = (const bf16_t*)(ws + WS_HID);
#pragma unroll 1
            for (int hf = 0; hf < 2; ++hf) {
                const int j = col + 1024 * hf;
                const float gg = chk_dot(HNp + (size_t)row * D, p->in[I_WGU1], 2 * DFF, j, D, ln), uu = chk_dot(HNp + (size_t)row * D, p->in[I_WGU1], 2 * DFF, DFF + j, D, ln);
                const float ref = gg / (1.f + expf(-gg)) * uu, got = bf2f(HIDp[(size_t)row * DFF + j]);
                if (fabsf(ref - got) > 0.03f * (fabsf(ref) + 0.3f)) ++nb;
                ++nt;
            }
        } else {
            const float a = chk_dot(OB + (size_t)row * D, p->in[I_WBR], D, col, D, ln), b = chk_dot(SB + (size_t)row * D, p->in[I_WBR] + (size_t)D * D, D, col, D, ln);
            const float ref = bf2f(GT[(size_t)row * 2048 + col]) * a + bf2f(GT[(size_t)row * 2048 + 1024 + col]) * b, got = bf2f(MX[(size_t)row * D + col]);
            if (fabsf(ref - got) > 0.03f * (fabsf(ref) + 0.3f)) ++nb;
            ++nt;
        }
    }
#ifdef CHK4_ROWWISE
    if (ln == 0) { atomicMax(dbg + 1 + 2 * which, nb); if (nb) atomicAdd(dbg + 9, 1u); }
#else
    if (ln == 0) { if (nb) atomicAdd(dbg + 1 + 2 * which, nb); atomicAdd(dbg + 2 + 2 * which, nt); }
#endif
    __syncthreads();
}
#endif
#ifndef MX_MASK
#define MX_MASK 15
#endif
#ifndef ATTN_REPS
#define ATTN_REPS 1
#endif
#ifndef UP_REPS
#define UP_REPS 1
#endif
#ifndef SP_REPS
#define SP_REPS 1
#endif
#ifndef SA_REPS
#define SA_REPS 1
#endif
#ifndef PRO_REPS
#define PRO_REPS 1
#endif
#ifndef NORM_REPS
#define NORM_REPS 1
#endif
__device__ __forceinline__ void mixer_phase(KP p, LAS unsigned char* lds, int vcu) {
    const int lane = tid_opaque() & 63;
    unsigned char* ws = p->ws;
    bf16_t* Q = (bf16_t*)(ws + WS_Q); const bf16_t* KB = (const bf16_t*)(ws + WS_KB); const bf16_t* VB = (const bf16_t*)(ws + WS_VB);
#if defined(SELFCHK) || defined(O_SEPARATE)
    bf16_t* OB = (bf16_t*)(ws + WS_O2);
#else
    bf16_t* OB = Q;
#endif
    bf16_t* U = (bf16_t*)(ws + WS_U); const bf16_t* GV = (const bf16_t*)(ws + WS_GV); const float* SSQ = (const float*)(ws + WS_SSQ);
    const float* lq = p->in[I_LQK];
    const float d1 = wave_sum(lq[lane] * lq[64 + lane]), d2 = wave_sum(lq[128 + lane] * lq[192 + lane]);
    const float lam = expf(d1) - expf(d2) + 0.2f;
    const float gqm = wave_max(fabsf(p->in[I_QG][lane])), gkm = wave_max(fabsf(p->in[I_KG][lane]));
    const float M2 = 8.f * gqm * gkm * 1.02f * LOG2E;
    if (MX_MASK & 1) { const int bh = vcu >> 2; for (int r_ = 0; r_ < SA_REPS; ++r_) sample_attn_unit(p, Q, (r_ + 1 < SA_REPS) ? (bf16_t*)(ws + 840 * MiB) : OB, bh >> 3, bh & 7, vcu & 3, lam, lds); }
    if ((MX_MASK & 2) && (vcu & 3) == 1 && (vcu >> 2) < 8) sample_spatial_unit(GV, U, SSQ, p->in[I_VNG], p->in[I_GWS], p->in[I_GBS], p->out + O_GS, vcu >> 2, lds);
    if (MX_MASK & 4) for (int r_ = 0; r_ < SP_REPS; ++r_) for (int ci = vcu; ci < MP / 128; ci += 256) spatial_unit(GV, U, SSQ, p->in[I_VNG], p->in[I_GWS], p->in[I_GBS], ci, lds, ws + WS_WF, p->ws + WS_END + 32768, (r_ + 1 < SP_REPS) ? (bf16_t*)(ws + 840 * MiB) : nullptr);
    __syncthreads();
    if (MX_MASK & 8) {
        const int b = vcu >> 5, pp = vcu & 31;
#pragma unroll 1
        for (int rep_ = 0; rep_ < ATTN_REPS; ++rep_)
#pragma unroll 1
        for (int h = 7; h >= 0; --h) {
            const float win = (2.f * M2 + 46.f) / ldexpf(LOG2E, -(h + 1));
            int ph = (pp + (int)((0x4a6d64a3dcULL >> (5 * h)) & 31)) & 31; if ((0x66 >> h) & 1) ph = 31 - ph;
            bf16_t* Od = (rep_ + 1 < ATTN_REPS) ? (bf16_t*)(ws + 840 * MiB) : OB;
            attn_unit(Q, KB, VB, Od, p->in[I_SUBG], b, h, 63 - ph, lds, lam, M2, win);
            attn_unit(Q, KB, VB, Od, p->in[I_SUBG], b, h, ph, lds, lam, M2, win);
        }
    }
}

#define RLX_AGENT __ATOMIC_RELAXED, __HIP_MEMORY_SCOPE_AGENT
#ifndef FENCE_SCOPE
#define FENCE_SCOPE ""
#endif
#define XB_TMO      128
#define XB_XCNT(j)  (256  + 64 * (j))
#define XB_XSUB(j)  (1280 + 64 * (j))
#define XB_XGEN(j)  (2304 + 64 * (j))
#define XB_TOP      3328
#define XB_TOPGEN   3392
#define XCD_BAR_WORDS 3456
#define XB_SPIN_CAP (1u << 18)

__device__ __forceinline__ unsigned xb_ld(unsigned* p)              { return __hip_atomic_load(p, __ATOMIC_RELAXED, __HIP_MEMORY_SCOPE_AGENT); }
__device__ __forceinline__ unsigned xb_add(unsigned* p, unsigned v) { return __hip_atomic_fetch_add(p, v, __ATOMIC_RELAXED, __HIP_MEMORY_SCOPE_AGENT); }
__device__ __forceinline__ unsigned xb_xcc_id() { return (unsigned)__builtin_amdgcn_s_getreg((3 << 11) | 20) & 0xFu; }
#define XB_SPIN(cond, bar) do { unsigned _sp = 0; while (cond) { __builtin_amdgcn_s_sleep(1); \
    if ((++_sp & 255u) == 0u) { if (xb_ld(&(bar)[XB_TMO])) break; if (_sp > XB_SPIN_CAP) { atomicAdd(&(bar)[XB_TMO], 1u); break; } } } } while (0)

struct XcdBarrier {
    unsigned* bar; unsigned x;
    volatile LAS unsigned* st;
};

__device__ __forceinline__ XcdBarrier xcd_barrier_post(unsigned* bar, volatile LAS unsigned* st) {
    XcdBarrier b; b.bar = bar; b.x = xb_xcc_id(); b.st = st;
    if (threadIdx.x == 0) (void)xb_add(&bar[XB_XCNT(b.x)], 1u);
    return b;
}
__device__ __forceinline__ void xcd_barrier_complete(unsigned* bar, unsigned x, unsigned& nloc, unsigned& nx) {
    const unsigned G = gridDim.x * gridDim.y * gridDim.z;
    unsigned sum, cnt, mine, sp = 0u;
    for (;;) {
        sum = 0u; cnt = 0u; mine = 0u;
#pragma unroll
        for (unsigned j = 0; j < 16; ++j) { const unsigned c = xb_ld(&bar[XB_XCNT(j)]); sum += c; cnt += (c > 0u) ? 1u : 0u; mine = (j == x) ? c : mine; }
        if (sum == G) break;
        __builtin_amdgcn_s_sleep(1);
        if ((++sp & 255u) == 0u) { if (xb_ld(&bar[XB_TMO])) break; if (sp > XB_SPIN_CAP) { atomicAdd(&bar[XB_TMO], 1u); break; } }
    }
    nloc = mine > 0u ? mine : 1u; nx = cnt > 0u ? cnt : 1u;
}

__device__ __forceinline__ void xcd_barrier(const XcdBarrier& b) {
    asm volatile("s_waitcnt vmcnt(0)" ::: "memory");
    __syncthreads();
    if (threadIdx.x == 0) {
        unsigned* bar = b.bar;
        __builtin_amdgcn_s_waitcnt(0);
        unsigned nloc = b.st[0], nx = b.st[1];
        if (nloc == 0u) { xcd_barrier_complete(bar, b.x, nloc, nx); b.st[0] = nloc; b.st[1] = nx; }
        const unsigned old = xb_add(&bar[XB_XSUB(b.x)], 1u);
        const unsigned gen = old / nloc;
        if (old + 1u == (gen + 1u) * nloc) {
            __builtin_amdgcn_fence(__ATOMIC_RELEASE, FENCE_SCOPE);
            asm volatile("s_waitcnt vmcnt(0)" ::: "memory");
            const unsigned og = xb_add(&bar[XB_TOP], 1u);
            const unsigned tg = og / nx;
            if (og + 1u == (tg + 1u) * nx) xb_add(&bar[XB_TOPGEN], 1u);
            else XB_SPIN(xb_ld(&bar[XB_TOPGEN]) == tg, bar);
            __builtin_amdgcn_fence(__ATOMIC_ACQUIRE, FENCE_SCOPE);
            xb_add(&bar[XB_XGEN(b.x)], 1u);
            asm volatile("s_waitcnt vmcnt(0)" ::: "memory");
        } else {
            XB_SPIN(xb_ld(&bar[XB_XGEN(b.x)]) == gen, bar);
            __builtin_amdgcn_fence(__ATOMIC_ACQUIRE, FENCE_SCOPE);
            asm volatile("s_waitcnt vmcnt(0)" ::: "memory");
        }
    }
    __syncthreads();
}

constexpr size_t WS_BAR = WS_END;
constexpr size_t WS_BAR_BYTES = 65536, WS_TOTAL = WS_BAR + WS_BAR_BYTES;
constexpr int LDS_XB = 139264;
__device__ __forceinline__ void seam_barrier(const XcdBarrier& b) {
#ifdef HEAVY_SEAM
    asm volatile("s_waitcnt vmcnt(0)\n\tbuffer_wbl2 sc0 sc1\n\ts_waitcnt vmcnt(0)\n\tbuffer_inv sc0 sc1\n\ts_waitcnt vmcnt(0)" ::: "memory");
#endif
    xcd_barrier(b);
#ifdef HEAVY_SEAM
    asm volatile("buffer_inv sc0 sc1\n\ts_waitcnt vmcnt(0)" ::: "memory");
    __syncthreads();
#endif
}
__device__ __forceinline__ void grid_barrier(cg::grid_group& grid) {
    asm volatile("s_waitcnt vmcnt(0)" ::: "memory");
    __syncthreads();
    if (threadIdx.x < 64) { __builtin_amdgcn_fence(__ATOMIC_RELEASE, FENCE_SCOPE); asm volatile("s_waitcnt vmcnt(0)" ::: "memory"); }
    grid.sync();
    __builtin_amdgcn_fence(__ATOMIC_ACQUIRE, FENCE_SCOPE);
    asm volatile("s_waitcnt vmcnt(0)" ::: "memory");
}
#if defined(SELFCHK) || defined(O_SEPARATE)
constexpr size_t WS_OSRC = WS_O2;
#else
constexpr size_t WS_OSRC = WS_Q;
#endif
#ifndef PH_MASK
#define PH_MASK 0xFFFF
#endif
#ifndef CHK_ITERS
#define CHK_ITERS 4
#endif
#ifndef CHK5_M0
#define CHK5_M0 0
#define CHK5_M1 6
#endif
#ifndef CHK4_REPORT
#define CHK4_REPORT (1000.f * (1.f + (float)nbad / 16.f))
#endif
#ifndef CHK4_ROWS
#define CHK4_ROWS MP
#endif
#ifndef CHK4_ROW0
#define CHK4_ROW0 0
#endif
#ifndef CHK4_WHICH
#define CHK4_WHICH 0
#endif
#ifndef CHK3_ROWS
#define CHK3_ROWS MP
#endif
#ifndef CHK_ATT_ITERS
#define CHK_ATT_ITERS CHK_ITERS
#endif
#ifndef CHK_REPORT
#define CHK_REPORT (1000.f + 100000.f * (float)nbad / (float)(ntot + 1))
#endif
#ifndef CHK_OFF
#define CHK_OFF(o) ((o) & 60)
#endif
#ifndef CHK_FILTER
#define CHK_FILTER
#endif
#ifndef STEP_LIMIT
#define STEP_LIMIT 13
#endif
__global__ void __launch_bounds__(512, 2) fwd_megakernel(Params p_unused) {
    extern __shared__ __attribute__((aligned(16))) unsigned char lds_raw[];
    LAS unsigned char* lds = (LAS unsigned char*)lds_raw;
    cg::grid_group grid = cg::this_grid();
    if (threadIdx.x < 2) ((volatile LAS unsigned*)(lds + LDS_XB))[threadIdx.x] = 0u;
    __syncthreads();
    const XcdBarrier xbar = xcd_barrier_post((unsigned*)(kparams()->ws + WS_BAR), (volatile LAS unsigned*)(lds + LDS_XB));
    grid.sync();
    const int G0 = gridDim.x, bx0 = blockIdx.x;
    const int vcu0 = (G0 % 8 == 0) ? (bx0 % 8) * (G0 / 8) + bx0 / 8 : bx0;
#pragma unroll 1
    for (int step = 0; step < 14; ++step) {
        const KP kp = kparams();
        if (step > STEP_LIMIT && step != 13) { seam_barrier(xbar); continue; }
        int G = G0, bx = bx0, vcu = vcu0; asm volatile("" : "+s"(G), "+s"(bx), "+s"(vcu));
        if (step == 0 && (PH_MASK & 1)) {
            for (int r_ = 0; r_ < PRO_REPS; ++r_) { prologue(kp, lds, vcu, G); __syncthreads(); }
        } else if ((step == 1 || step == 4 || step == 10 || step == 13) && (PH_MASK & 2)) {
            for (int r_ = 0; r_ < ((step == 13) ? 1 : NORM_REPS); ++r_) norm_rows(kp, step == 1 ? 0 : step == 4 ? 1 : step == 10 ? 2 : 3, vcu, G);
        } else if ((step == 2 || step == 11) && (PH_MASK & 4)) {
#pragma unroll 1
            for (int part = 0; part < 2 * UP_REPS; ++part) {
                unsigned char* ws = kp->ws; const int roff = (part & 1) ? MP : 0;
                pg8::Gemm g{(const bf16_t*)(ws + WS_HN) + (size_t)roff * D, (const bf16_t*)(ws + (step == 2 ? WS_WGU1 : WS_WGU2)), (part & 1) ? 256 : MP, 2 * DFF, D};
                pg8::StaticOrder S; S.init((part & 1) ? 256 : MP, 2 * DFF, G, bx);
                EpiUp E{kp, roff};
                if (part) pg8::gemm_phase<EpiUp, pg8::StaticOrder, true, true, true>(lds, g, S, E); else pg8::gemm_phase<EpiUp, pg8::StaticOrder, true, true, false>(lds, g, S, E);
            }
#ifdef SELFCHK4
            if (step == 2) { seam_barrier(xbar); check_gemms(kp, 2, vcu, G); }
#endif
#ifdef SELFCHK5
            if (step == SELFCHK5) {
                seam_barrier(xbar);
                unsigned char* ws5 = kp->ws; unsigned nb5 = 0; const int t5 = tid_opaque();
                const float* srcs[6] = {kp->in[I_WGATE], kp->in[I_WBR], kp->in[I_WBR] + (size_t)D * D, kp->in[I_WOUT], kp->in[I_WD1], kp->in[I_WD2]};
                const size_t offs[6] = {WS_WGT, WS_WBA, WS_WBB, WS_WOUT, WS_WD1, WS_WD2};
                const int Ns[6] = {2048, D, D, D, D, D}, Ks[6] = {D, D, D, D, DFF, DFF};
                for (int mi = CHK5_M0; mi < CHK5_M1; ++mi) {
                    const bf16_t* WT = (const bf16_t*)(ws5 + offs[mi]); const float* W = srcs[mi]; const int N5 = Ns[mi], K5 = Ks[mi];
                    for (size_t e = (size_t)vcu * 512 + t5; e < (size_t)N5 * K5; e += (size_t)G * 512) {
                        const int n = (int)(e / K5), k = (int)(e % K5);
                        if (WT[e] != f2bf(W[(size_t)k * N5 + n])) ++nb5;
                    }
                }
                if (nb5) atomicAdd((unsigned*)(ws5 + WS_END + 32768) + 1, nb5);
                __syncthreads();
            }
#endif
        } else if ((step == 3 || step == 12 || step == 9) && (PH_MASK & 8)) {
#pragma unroll 1
            for (int part = 0; part < 2; ++part) {
                unsigned char* ws = kp->ws; const int roff = part ? MP : 0; const int K = step == 9 ? D : DFF;
                pg8::Gemm g{(const bf16_t*)(ws + (step == 9 ? WS_MIXED : WS_HID)) + (size_t)roff * K, (const bf16_t*)(ws + (step == 3 ? WS_WD1 : step == 12 ? WS_WD2 : WS_WOUT)), part ? 256 : MP, D, K};
                pg8::StaticOrder S; S.init(part ? 256 : MP, D, G, bx);
                EpiRes E{kp, step == 3 ? 2 : step == 9 ? 5 : 8, step == 9 ? 1.f : 0.5f, step == 3 ? 1 : 0, roff};
                if (part) pg8::gemm_phase<EpiRes, pg8::StaticOrder, true, true, true>(lds, g, S, E); else pg8::gemm_phase<EpiRes, pg8::StaticOrder, true, true, false>(lds, g, S, E);
            }
        } else if (step == 5 && (PH_MASK & 16)) {
#pragma unroll 1
            for (int part = 0; part < 2; ++part) {
                unsigned char* ws = kp->ws; const int roff = part ? MP : 0;
                pg8::Gemm g{(const bf16_t*)(ws + WS_HN2) + (size_t)roff * D, (const bf16_t*)(ws + WS_WIN), part ? 256 : MP, 5120, D};
                pg8::StaticOrder S; S.init(part ? 256 : MP, 5120, G, bx);
                EpiIn E{kp, roff};
                if (part) pg8::gemm_phase<EpiIn, pg8::StaticOrder, true, true, true>(lds, g, S, E); else pg8::gemm_phase<EpiIn, pg8::StaticOrder, true, true, false>(lds, g, S, E);
            }
        } else if (step == 6 && (PH_MASK & 32)) {
            mixer_phase(kp, lds, vcu);
        } else if (step == 7 && (PH_MASK & 64)) {
#ifdef SELFCHK3
            {
                const bf16_t* OB = (const bf16_t*)(kp->ws + WS_Q); const int tid3 = tid_opaque(), ln = tid3 & 63, wv = tid3 >> 6;
                unsigned nb = 0;
                for (int row = vcu * 8 + wv; row < CHK3_ROWS; row += G * 8) {
                    for (int hh = 0; hh < 8; ++hh) {
                        const unsigned w = *(const unsigned*)(OB + (size_t)row * D + hh * 128 + 2 * ln);
                        const float a = bf_lo(w), b = bf_hi(w);
                        const float ms = wave_sum(a * a + b * b) * (1.f / 128.f);
                        if (!(ms > 0.3f && ms < 1.2f)) ++nb;
                    }
                }
                if (ln == 0 && nb) atomicAdd((unsigned*)(kp->ws + WS_END + 32768) + 1, nb);
                __syncthreads();
                seam_barrier(xbar);
            }
#endif
#pragma unroll 1
            for (int part = 0; part < 2; ++part) {
                unsigned char* ws = kp->ws; const int roff = part ? MP : 0;
                pg8::Gemm g{(const bf16_t*)(ws + WS_HN2) + (size_t)roff * D, (const bf16_t*)(ws + WS_WGT), part ? 256 : MP, 2048, D};
                pg8::StaticOrder S; S.init(part ? 256 : MP, 2048, G, bx);
                EpiGates E{kp, roff};
                if (part) pg8::gemm_phase<EpiGates, pg8::StaticOrder, true, true, true>(lds, g, S, E); else pg8::gemm_phase<EpiGates, pg8::StaticOrder, true, true, false>(lds, g, S, E);
            }
#ifdef SELFCHK4
            seam_barrier(xbar); check_gemms(kp, 0, vcu, G);
#endif
        } else if (step == 8 && (PH_MASK & 128)) {
#pragma unroll 1
            for (int hp = 0; hp < 4; ++hp) {
                const int half = hp & 1, part = hp >> 1;
                unsigned char* ws = kp->ws; const int roff = part ? MP : 0;
                pg8::Gemm g{(const bf16_t*)(ws + (half ? WS_U : WS_Q)) + (size_t)roff * D, (const bf16_t*)(ws + (half ? WS_WBB : WS_WBA)), part ? 256 : MP, D, D};
                pg8::StaticOrder S; S.init(part ? 256 : MP, D, G, bx);
                EpiBr E{kp, half * D, half, roff};
                if (part) pg8::gemm_phase<EpiBr, pg8::StaticOrder, true, true, true>(lds, g, S, E); else pg8::gemm_phase<EpiBr, pg8::StaticOrder, true, true, false>(lds, g, S, E);
            }
#ifdef SELFCHK4
            seam_barrier(xbar); check_gemms(kp, 1, vcu, G);
#endif
        }
#if defined(SELFCHK4) || defined(SELFCHK5)
        if (step == 13 && bx0 == 0 && threadIdx.x == 0) { unsigned* dbg = (unsigned*)(kp->ws + WS_END + 32768); const unsigned nbad = __hip_atomic_load(dbg + 1 + 2 * CHK4_WHICH, __ATOMIC_RELAXED, __HIP_MEMORY_SCOPE_AGENT); kp->out[1] = CHK4_REPORT; }
#endif
#ifdef SELFCHK3
        if (step == 13 && bx0 == 0 && threadIdx.x == 0) { const unsigned nbad = __hip_atomic_load((unsigned*)(kp->ws + WS_END + 32768) + 1, __ATOMIC_RELAXED, __HIP_MEMORY_SCOPE_AGENT); kp->out[1] = 1000.f * (1.f + (float)nbad / 16.f); }
#endif
#ifdef SELFCHK
        if (step == 13 && bx0 == 0 && threadIdx.x == 0) { const float rel = __uint_as_float(__hip_atomic_load((unsigned*)(kp->ws + WS_DBG), __ATOMIC_RELAXED, __HIP_MEMORY_SCOPE_AGENT)); const unsigned nbad = __hip_atomic_load((unsigned*)(kp->ws + WS_DBG) + 1, __ATOMIC_RELAXED, __HIP_MEMORY_SCOPE_AGENT), ntot = __hip_atomic_load((unsigned*)(kp->ws + WS_DBG) + 2, __ATOMIC_RELAXED, __HIP_MEMORY_SCOPE_AGENT);
            kp->out[1] = CHK_REPORT; }
#endif
        if (step < 13) seam_barrier(xbar);
    }
}

extern "C" void kernel_launch(void* const* d_in, const int* in_sizes, int n_in, void* d_out, int out_size, void* d_ws, size_t ws_size, hipStream_t stream) {
    static int grid = 0;
    if (grid == 0) {
        if (n_in != 25 || (size_t)out_size != O_END || ws_size < WS_TOTAL) { fprintf(stderr, "kernel_launch: unexpected shapes (n_in %d out %d ws %zu)\n", n_in, out_size, ws_size); grid = -1; return; }
        int dev = 0, cus = 0, per_cu = 0;
        hipGetDevice(&dev);
        hipDeviceGetAttribute(&cus, hipDeviceAttributeMultiprocessorCount, dev);
        if (hipFuncSetAttribute((const void*)fwd_megakernel, hipFuncAttributeMaxDynamicSharedMemorySize, LDS_BYTES) != hipSuccess) { fprintf(stderr, "kernel_launch: hipFuncSetAttribute failed\n"); grid = -1; return; }
        if (hipOccupancyMaxActiveBlocksPerMultiprocessor(&per_cu, (const void*)fwd_megakernel, 512, LDS_BYTES) != hipSuccess || per_cu < 1) { fprintf(stderr, "kernel_launch: occupancy query says %d\n", per_cu); per_cu = 1; }
        (void)hipGetLastError();
        grid = cus * per_cu;
    }
    if (grid < 0) return;
    if (hipMemsetAsync((char*)d_ws + WS_BAR, 0, WS_BAR_BYTES, stream) != hipSuccess) { fprintf(stderr, "kernel_launch: memset failed\n"); return; }
    Params p{};
    for (int i = 0; i < 25; ++i) p.in[i] = (const float*)d_in[i];
    p.out = (float*)d_out; p.ws = (unsigned char*)d_ws;
    void* args[] = {&p};
    hipError_t e = hipLaunchCooperativeKernel((const void*)fwd_megakernel, dim3(grid), dim3(512), args, LDS_BYTES, stream);
    if (e != hipSuccess) fprintf(stderr, "cooperative launch failed: %s (grid %d)\n", hipGetErrorString(e), grid);
}
```
